# Optimizing an MI355X kernel written in HIP

```python
import jax, jax.numpy as jnp
from jax import lax
import numpy as np

D_MODEL = 2048
BATCH = 1
SEQ = 8192
DEPTH = 1

HEAD_DIM = 128
ATTN_WIDTH = D_MODEL // 2
ATTN_HEADS = ATTN_WIDTH // HEAD_DIM
POOL_WIDTH = D_MODEL // 2
POOL_WINDOWS = (2, 4, 8, 16)
POOL_GROUPS = len(POOL_WINDOWS)
POOL_GROUP_WIDTH = POOL_WIDTH // POOL_GROUPS
DILATED_PATTERNS = ((128, 1), (512, 4), (2048, 16))
SUB_BLOCK = 128
D_FF = 4 * D_MODEL
ROPE_THETA = 10000.0
LN_EPS = 1e-5
DEEPNORM_ALPHA = (2.0 * DEPTH) ** 0.25
DEEPNORM_BETA = (8.0 * DEPTH) ** -0.25
IN_SPLITS = (ATTN_WIDTH, 2 * ATTN_WIDTH, 3 * ATTN_WIDTH, 3 * ATTN_WIDTH + POOL_WIDTH,
             3 * ATTN_WIDTH + POOL_WIDTH + D_MODEL)
IN_WIDTH = 3 * ATTN_WIDTH + POOL_WIDTH + 2 * D_MODEL

kernel_name = "dilated_attn_pool_gated_hybrid_deepnorm"


def layer_norm(x, g, b):
    xf = x.astype(jnp.float32)
    mu = jnp.mean(xf, axis=-1, keepdims=True)
    var = jnp.mean(jnp.square(xf - mu), axis=-1, keepdims=True)
    return ((xf - mu) * lax.rsqrt(var + LN_EPS) * g.astype(jnp.float32) + b.astype(jnp.float32)).astype(x.dtype)


def rope(t, positions):
    half = HEAD_DIM // 2
    inv_freq = ROPE_THETA ** (-jnp.arange(half, dtype=jnp.float32) / half)
    ang = positions.astype(jnp.float32)[..., None] * inv_freq
    cos = jnp.cos(ang)[:, :, None, :]
    sin = jnp.sin(ang)[:, :, None, :]
    t1 = t[..., :half].astype(jnp.float32)
    t2 = t[..., half:].astype(jnp.float32)
    return jnp.concatenate([t1 * cos - t2 * sin, t2 * cos + t1 * sin], axis=-1).astype(t.dtype)


def dilated_window_attention(q, k, v, window, dilation):
    B, S, H, Dh = q.shape
    span = window // dilation
    blk = SUB_BLOCK
    assert span <= blk
    unit = dilation * blk
    s_pad = -(-S // unit) * unit
    m_len = s_pad // dilation
    nb = m_len // blk

    def to_blocks(t):
        t = jnp.pad(t, ((0, 0), (0, s_pad - S), (0, 0), (0, 0)))
        t = t.reshape(B, m_len, dilation, H, Dh).transpose(0, 2, 1, 3, 4)
        return t.reshape(B, dilation, nb, blk, H, Dh)

    def with_prev(t):
        prev = jnp.pad(t, ((0, 0), (0, 0), (1, 0), (0, 0), (0, 0), (0, 0)))[:, :, :-1]
        return jnp.concatenate([prev, t], axis=3)

    qb = to_blocks(q)
    kw = with_prev(to_blocks(k))
    vw = with_prev(to_blocks(v))
    s = jnp.einsum('brnqhd,brnkhd->brnhqk', qb, kw,
                   preferred_element_type=jnp.float32) * (HEAD_DIM ** -0.5)
    qi = jnp.arange(blk)[:, None]
    kj = jnp.arange(2 * blk)[None, :]
    dist = qi + blk - kj
    band = (dist >= 0) & (dist <= span)
    valid = band[None] & ((jnp.arange(nb)[:, None, None] > 0) | (kj >= blk)[None])
    s = jnp.where(valid[None, None, :, None], s, -jnp.inf)
    mx = jnp.max(s, axis=-1, keepdims=True)
    p = jnp.exp(s - mx)
    l = jnp.sum(p, axis=-1)
    o = jnp.einsum('brnhqk,brnkhd->brnqhd', p, vw.astype(jnp.float32))
    o = o / jnp.swapaxes(l, 3, 4)[..., None]
    lse = jnp.swapaxes(mx[..., 0] + jnp.log(l), 3, 4)
    o = o.reshape(B, dilation, m_len, H, Dh).transpose(0, 2, 1, 3, 4).reshape(B, s_pad, H, Dh)[:, :S]
    lse = lse.reshape(B, dilation, m_len, H).transpose(0, 2, 1, 3).reshape(B, s_pad, H)[:, :S]
    return o, lse


def pool_mixer(u, w_pool, pool_scale):
    B, S, _ = u.shape
    ug = u.reshape(B, S, POOL_GROUPS, POOL_GROUP_WIDTH)
    pooled = []
    for g, w in enumerate(POOL_WINDOWS):
        xg = ug[:, :, g].astype(jnp.float32)
        c = jnp.cumsum(xg, axis=1)
        c_lag = jnp.pad(c, ((0, 0), (w, 0), (0, 0)))[:, :S]
        count = jnp.minimum(jnp.arange(1, S + 1), w).astype(jnp.float32)[None, :, None]
        pooled.append((c - c_lag) / count - xg)
    p = jnp.stack(pooled, axis=2).astype(u.dtype)
    y = jnp.einsum('bsgc,gcd->bsgd', p, w_pool).reshape(B, S, POOL_WIDTH)
    return y * pool_scale


def setup_inputs(seed: int = 0) -> dict:
    key = jax.random.key(seed)
    ks = jax.random.split(key, 20)
    f32 = jnp.float32

    def nrm(k, shape, fan_in, gain=1.0):
        return jax.random.normal(k, shape, f32) * (gain * fan_in ** -0.5)

    x = jax.random.normal(ks[0], (BATCH, SEQ, D_MODEL), f32)
    positions = (jnp.arange(SEQ, dtype=jnp.int32)[None, :]
                 + jax.random.randint(ks[1], (BATCH, 1), 0, 1024, dtype=jnp.int32))
    w_in = jnp.concatenate([
        nrm(ks[2], (DEPTH, D_MODEL, 2 * ATTN_WIDTH), D_MODEL),
        nrm(ks[3], (DEPTH, D_MODEL, ATTN_WIDTH), D_MODEL, DEEPNORM_BETA),
        nrm(ks[4], (DEPTH, D_MODEL, POOL_WIDTH), D_MODEL),
        nrm(ks[5], (DEPTH, D_MODEL, 2 * D_MODEL), D_MODEL),
    ], axis=-1)
    w_pool = nrm(ks[6], (DEPTH, POOL_GROUPS, POOL_GROUP_WIDTH, POOL_GROUP_WIDTH), POOL_GROUP_WIDTH)
    pool_scale = 1.0 + 0.1 * jax.random.normal(ks[7], (DEPTH, POOL_WIDTH), f32)
    w_branch_attn = nrm(ks[8], (DEPTH, ATTN_WIDTH, D_MODEL), ATTN_WIDTH, DEEPNORM_BETA)
    w_branch_pool = nrm(ks[9], (DEPTH, POOL_WIDTH, D_MODEL), POOL_WIDTH, DEEPNORM_BETA)
    w_out = nrm(ks[10], (DEPTH, D_MODEL, D_MODEL), D_MODEL, DEEPNORM_BETA)
    ln_mix_g = 1.0 + 0.05 * jax.random.normal(ks[11], (DEPTH, D_MODEL), f32)
    ln_mix_b = 0.02 * jax.random.normal(ks[12], (DEPTH, D_MODEL), f32)
    w_ff1 = nrm(ks[13], (DEPTH, D_MODEL, D_FF), D_MODEL, DEEPNORM_BETA)
    w_ff2 = nrm(ks[14], (DEPTH, D_FF, D_MODEL), D_FF, DEEPNORM_BETA)
    ln_ff_g = 1.0 + 0.05 * jax.random.normal(ks[15], (DEPTH, D_MODEL), f32)
    ln_ff_b = 0.02 * jax.random.normal(ks[16], (DEPTH, D_MODEL), f32)
    return {"x": x, "positions": positions, "w_in": w_in, "w_pool": w_pool,
            "pool_scale": pool_scale, "w_branch_attn": w_branch_attn,
            "w_branch_pool": w_branch_pool, "w_out": w_out, "ln_mix_g": ln_mix_g,
            "ln_mix_b": ln_mix_b, "w_ff1": w_ff1, "w_ff2": w_ff2,
            "ln_ff_g": ln_ff_g, "ln_ff_b": ln_ff_b}


def reference(x, positions, w_in, w_pool, pool_scale, w_branch_attn, w_branch_pool, w_out,
              ln_mix_g, ln_mix_b, w_ff1, w_ff2, ln_ff_g, ln_ff_b):
    B, S, _ = x.shape
    for layer in range(DEPTH):
        h = x @ w_in[layer]
        q, k, v, u, gate_attn, gate_pool = jnp.split(h, IN_SPLITS, axis=-1)
        q = rope(q.reshape(B, S, ATTN_HEADS, HEAD_DIM), positions)
        k = rope(k.reshape(B, S, ATTN_HEADS, HEAD_DIM), positions)
        v = v.reshape(B, S, ATTN_HEADS, HEAD_DIM)
        outs, lses = [], []
        for window, dilation in DILATED_PATTERNS:
            o_g, lse_g = dilated_window_attention(q, k, v, window, dilation)
            outs.append(o_g)
            lses.append(lse_g)
        mix_w = jax.nn.softmax(jnp.stack(lses, axis=0), axis=0)
        o_attn = jnp.einsum('pbsh,pbshd->bshd', mix_w, jnp.stack(outs, axis=0))
        y_attn = o_attn.reshape(B, S, ATTN_WIDTH).astype(x.dtype) @ w_branch_attn[layer]
        y_pool = pool_mixer(u, w_pool[layer], pool_scale[layer]) @ w_branch_pool[layer]
        merged = jax.nn.sigmoid(gate_attn) * y_attn + jax.nn.sigmoid(gate_pool) * y_pool
        mix = merged @ w_out[layer]
        x = layer_norm(DEEPNORM_ALPHA * x + mix, ln_mix_g[layer], ln_mix_b[layer])
        f = jnp.square(jax.nn.relu(x @ w_ff1[layer])) @ w_ff2[layer]
        x = layer_norm(DEEPNORM_ALPHA * x + f, ln_ff_g[layer], ln_ff_b[layer])
    return x
```

```cpp
#include <hip/hip_runtime.h>
#include <hip/hip_cooperative_groups.h>
#include <cstdio>
#include <cstdint>
namespace cg = cooperative_groups;

#ifndef N_LAUNCH_MODE
#define N_LAUNCH_MODE 0
#endif

#define LAS __attribute__((address_space(3)))
typedef unsigned short bf16_t;
typedef short bf16x8 __attribute__((ext_vector_type(8)));
typedef short s16x4 __attribute__((ext_vector_type(4)));
typedef float f32x4 __attribute__((ext_vector_type(4)));
typedef unsigned u32x4 __attribute__((ext_vector_type(4)));
typedef unsigned u32x2 __attribute__((ext_vector_type(2)));

constexpr int S = 8192, DM = 2048, IW = 8192, AW = 1024, FF = 8192, NH = 8;
constexpr float LN_EPS = 1e-5f;
constexpr float ALPHA = 1.189207115002721f;
constexpr float QSCALE = 0.08838834764831845f * 1.4426950408889634f;
constexpr int NPH = 10;

constexpr size_t MiB = 1u << 20;
constexpr size_t WS_ST1 = 65536, WS_ST2 = 82 * MiB + 524288  , WS_ZERO_BYTES = 32768;
static_assert(WS_ST1 + 524288 <= (1u << 20), "control MiB");
constexpr int FFP = FF + 64;
constexpr size_t WS_BT5 = 1 * MiB, WS_BT6 = 33 * MiB, WS_BT3 = 66 * MiB, WS_BT4 = 74 * MiB, WS_WPT = 82 * MiB, WS_COS = 83 * MiB, WS_SIN = 85 * MiB, WS_LSE = 87 * MiB;
constexpr size_t WS_X = 88 * MiB;
constexpr size_t WS_BT1 = WS_X, WS_XB = WS_X + 32 * MiB, WS_OP = WS_X, WS_P = WS_X + 48 * MiB, WS_MRG = WS_X, WS_X1B = WS_X;
constexpr size_t WS_H1 = 152 * MiB, WS_A3 = WS_H1, WS_G = 216 * MiB, WS_ACT = 152 * MiB, WS_END = 281 * MiB;
static_assert(WS_BT6 + (size_t)DM * FFP * 2 <= WS_BT3 && WS_ACT + (size_t)S * FFP * 2 <= WS_END, "workspace map");

constexpr int OST_OFF = 131072 + 1024;
constexpr int LDS_BYTES = OST_OFF + 8 * 2304;

typedef float f32x2_t __attribute__((ext_vector_type(2))); typedef __bf16 bf16x2_t __attribute__((ext_vector_type(2)));
__device__ __forceinline__ unsigned cvt_pk_bf16(float lo, float hi) { f32x2_t v = {lo, hi}; bf16x2_t b = __builtin_convertvector(v, bf16x2_t); return __builtin_bit_cast(unsigned, b); }
__device__ __forceinline__ float bf_lo(unsigned w) { return __builtin_bit_cast(float, w << 16); }
__device__ __forceinline__ float bf_hi(unsigned w) { return __builtin_bit_cast(float, w & 0xffff0000u); }
#define LDS_WAIT() asm volatile("s_waitcnt lgkmcnt(0)" ::: "memory")

#define XB_TMO      128
#define XB_XCNT(j)  (256  + 64 * (j))
#define XB_XSUB(j)  (1280 + 64 * (j))
#define XB_XGEN(j)  (2304 + 64 * (j))
#define XB_TOP      3328
#define XB_TOPGEN   3392
#define XCD_BAR_WORDS 3456
#define XB_SPIN_CAP (1u << 22)
__device__ __forceinline__ unsigned xb_ld(unsigned* p)              { return __hip_atomic_load(p, __ATOMIC_RELAXED, __HIP_MEMORY_SCOPE_AGENT); }
__device__ __forceinline__ unsigned xb_add(unsigned* p, unsigned v) { return __hip_atomic_fetch_add(p, v, __ATOMIC_RELAXED, __HIP_MEMORY_SCOPE_AGENT); }
__device__ __forceinline__ unsigned xb_xcc_id() { return (unsigned)__builtin_amdgcn_s_getreg((3 << 11) | 20) & 0xFu; }
#define XB_SPIN(cond, bar) do { unsigned _sp = 0; while (cond) { __builtin_amdgcn_s_sleep(1); \
    if ((++_sp & 255u) == 0u) { if (xb_ld(&(bar)[XB_TMO])) break; if (_sp > XB_SPIN_CAP) { atomicAdd(&(bar)[XB_TMO], 1u); break; } } } } while (0)
struct XcdBarrier { unsigned* bar; unsigned x; volatile LAS unsigned* st; };
__device__ __forceinline__ XcdBarrier xcd_barrier_post(unsigned* bar, volatile LAS unsigned* st) {
    XcdBarrier b; b.bar = bar; b.x = xb_xcc_id(); b.st = st;
    if (threadIdx.x == 0) (void)xb_add(&bar[XB_XCNT(b.x)], 1u);
    return b;
}
__device__ __forceinline__ void xcd_barrier_complete(unsigned* bar, unsigned x, unsigned& nloc, unsigned& nx) {
    const unsigned G = gridDim.x * gridDim.y * gridDim.z;
    unsigned sum, cnt, mine, sp = 0u;
    for (;;) {
        sum = 0u; cnt = 0u; mine = 0u;
#pragma unroll
        for (unsigned j = 0; j < 16; ++j) { const unsigned c = xb_ld(&bar[XB_XCNT(j)]); sum += c; cnt += (c > 0u) ? 1u : 0u; mine = (j == x) ? c : mine; }
        if (sum == G) break;
        __builtin_amdgcn_s_sleep(1);
        if ((++sp & 255u) == 0u) { if (xb_ld(&bar[XB_TMO])) break; if (sp > XB_SPIN_CAP) { atomicAdd(&bar[XB_TMO], 1u); break; } }
    }
    nloc = mine > 0u ? mine : 1u; nx = cnt > 0u ? cnt : 1u;
}
__device__ __forceinline__ void xcd_barrier(const XcdBarrier& b) {
    asm volatile("s_waitcnt vmcnt(0)" ::: "memory");
    __syncthreads();
    if (threadIdx.x == 0) {
        unsigned* bar = b.bar;
        __builtin_amdgcn_s_waitcnt(0);
        unsigned nloc = b.st[0], nx = b.st[1];
        if (nloc == 0u) { xcd_barrier_complete(bar, b.x, nloc, nx); b.st[0] = nloc; b.st[1] = nx; }
        const unsigned old = xb_add(&bar[XB_XSUB(b.x)], 1u);
        const unsigned gen = old / nloc;
        if (old + 1u == (gen + 1u) * nloc) {
            __builtin_amdgcn_fence(__ATOMIC_RELEASE, "agent");
            asm volatile("s_waitcnt vmcnt(0)" ::: "memory");
            const unsigned og = xb_add(&bar[XB_TOP], 1u);
            const unsigned tg = og / nx;
            if (og + 1u == (tg + 1u) * nx) xb_add(&bar[XB_TOPGEN], 1u);
            else XB_SPIN(xb_ld(&bar[XB_TOPGEN]) == tg, bar);
            __builtin_amdgcn_fence(__ATOMIC_ACQUIRE, "agent");
            xb_add(&bar[XB_XGEN(b.x)], 1u);
            asm volatile("s_waitcnt vmcnt(0)" ::: "memory");
        } else {
            XB_SPIN(xb_ld(&bar[XB_XGEN(b.x)]) == gen, bar);
            __builtin_amdgcn_fence(__ATOMIC_ACQUIRE, "agent");
            asm volatile("s_waitcnt vmcnt(0)" ::: "memory");
        }
    }
    __syncthreads();
}

namespace pg8 {
constexpr int BM = 256, BK = 64, HALF = 128, HTB = HALF * BK * 2, NXCD = 8, WGM = 2;
__host__ __device__ __forceinline__ int lds_byte(int r, int c) { const int st = (r >> 4) * 2 + (c >> 5), rr = r & 15, cc = c & 31, ob = rr * 64 + cc * 2; return st * 1024 + (ob ^ (((ob >> 9) & 1) << 5)); }
__host__ __device__ __forceinline__ void stage_rc(int b, int& R, int& C) { const int st = b / 1024, sb = b % 1024, swz = sb ^ (((sb >> 9) & 1) << 5); R = (st >> 1) * 16 + swz / 64; C = (st & 1) * 32 + (swz % 64) / 2; }
__host__ __device__ __forceinline__ int perm32(int rho) { const int n = rho >> 4, i = rho & 15; return 8 * (i >> 2) + 4 * n + (i & 3); }

struct Unit { int pm, pn; };
struct Gemm { const bf16_t* A; const bf16_t* Bt; int lda, ldb, K, apn; };

struct StaticOrder {
    int nM, nN, nwg, G, c, mix;
    __device__ void init(int M, int N, int G_, int c_, int mix_ = 0) { nM = M / BM; nN = N / BM; nwg = nM * nN; G = G_; c = c_; mix = mix_; }
    __device__ bool next(int i, Unit& u) const {
        const long L = (long)i * G + c; if (L >= nwg) return false;
        int wgid = (int)L; { const int q = nwg / NXCD, r = nwg % NXCD, xcd = wgid % NXCD, off = wgid / NXCD; wgid = (xcd < r ? xcd * (q + 1) : r * (q + 1) + (xcd - r) * q) + off; }
        const int nig = WGM * nN, gid = wgid / nig, fm = gid * WGM, gsz = (nM - fm) < WGM ? (nM - fm) : WGM;
        u.pm = fm + ((wgid % nig) % gsz); u.pn = (wgid % nig) / gsz;
        if (mix) { const int j = u.pn; u.pn = 16 * ((j >> 3) & 1) + 8 * ((j >> 4) & 1) + (j & 7); }
        return true;
    }
};

typedef f32x4 Acc[2][2][4][2];

template <class Epi>
__device__ __forceinline__ void gemm_phase(LAS unsigned char* lds, const Gemm g, const StaticOrder& S, const Epi& E) {
    const int tid = threadIdx.x, wid = __builtin_amdgcn_readfirstlane(tid >> 6), lane = tid & 63, wr = wid >> 2, wc = wid & 3, fr = lane & 15, fq = lane >> 4;
    const int K = g.K, nt = K / BK;
    unsigned voffA[2], voffB[2];
#pragma unroll
    for (int i = 0; i < 2; ++i) { int R, C; stage_rc(tid * 16 + i * 8192, R, C); const int Rb = Epi::PERM ? ((R & ~31) + perm32(R & 31)) : R;
        voffA[i] = (unsigned)(R * g.lda + C) * 2u; voffB[i] = (unsigned)(Rb * g.ldb + C) * 2u; }
    const size_t kstep = (size_t)(BK * 2);
    const size_t hstepA = (size_t)HALF * g.lda * 2, hstepB = (size_t)HALF * g.ldb * 2;
    const size_t tstepA = 2 * hstepA, tstepB = 2 * hstepB;
    const unsigned ldsw = (unsigned)wid * 1024u;
    const int aoff = lds_byte(wr * 64 + fr, fq * 8), boff = lds_byte(wc * 32 + fr, fq * 8);
#define PG8_SA(b, h) (((b) * 2 + (h)) * HTB)
#define PG8_SB(b, h) ((4 + (b) * 2 + (h)) * HTB)
#define PG8_STAGE(bufoff, gbase, voff) do { _Pragma("unroll") for (int _i = 0; _i < 2; ++_i) \
        __builtin_amdgcn_global_load_lds((const unsigned*)((const char*)(gbase) + (voff)[_i]), (LAS unsigned*)(lds + (bufoff) + ldsw + _i * 8192), 16, 0, 0); } while (0)
#define PG8_LDA(dst, b, h) do { _Pragma("unroll") for (int m = 0; m < 4; ++m) _Pragma("unroll") for (int k = 0; k < 2; ++k) dst[m][k] = *(const LAS bf16x8*)(lds + PG8_SA(b, h) + aoff + m * 2048 + k * 1024); } while (0)
#define PG8_LDB(dst, b, h) do { _Pragma("unroll") for (int n = 0; n < 2; ++n) _Pragma("unroll") for (int k = 0; k < 2; ++k) dst[n][k] = *(const LAS bf16x8*)(lds + PG8_SB(b, h) + boff + n * 2048 + k * 1024); } while (0)
#define PG8_MMA(ai, bj, At, Bt) do { __builtin_amdgcn_s_setprio(1); _Pragma("unroll") for (int m = 0; m < 4; ++m) _Pragma("unroll") for (int n = 0; n < 2; ++n) _Pragma("unroll") for (int k = 0; k < 2; ++k) \
        acc[ai][bj][m][n] = __builtin_amdgcn_mfma_f32_16x16x32_bf16(Bt[n][k], At[m][k], acc[ai][bj][m][n], 0, 0, 0); __builtin_amdgcn_s_setprio(0); } while (0)
#define PG8_WAIT_V(n) asm volatile("s_waitcnt vmcnt(" #n ")" ::: "memory")
#define PG8_WAIT_L(n) asm volatile("s_waitcnt lgkmcnt(" #n ")" ::: "memory")
#define PG8_BAR __builtin_amdgcn_s_barrier()
#define PG8_SCHED __builtin_amdgcn_sched_barrier(0)
    Unit cur, nxt; int ui = 0;
#define PG8_NEXT(i, u) (Epi::MID ? S.next((i) >> 1, u) : S.next((i), u))
#define PG8_KOFF(i) (Epi::MID ? (size_t)((i) & 1) * (size_t)K * 2 : (size_t)0)
    if (!PG8_NEXT(0, cur)) return;
    Acc acc;
#pragma unroll
    for (int a = 0; a < 2; ++a)
#pragma unroll
        for (int b = 0; b < 2; ++b)
#pragma unroll
            for (int m = 0; m < 4; ++m)
#pragma unroll
                for (int n = 0; n < 2; ++n) acc[a][b][m][n] = (f32x4){0.f, 0.f, 0.f, 0.f};
    bf16x8 At[4][2], B0[2][2], B1[2][2];
    const char* cA = (const char*)g.A + (size_t)cur.pm * tstepA + (size_t)cur.pn * g.apn + PG8_KOFF(0); const char* cB = (const char*)g.Bt + (size_t)cur.pn * tstepB + PG8_KOFF(0);
    PG8_STAGE(PG8_SB(0, 0), cB, voffB); PG8_STAGE(PG8_SB(0, 1), cB + hstepB, voffB); PG8_STAGE(PG8_SA(0, 0), cA, voffA); PG8_STAGE(PG8_SA(0, 1), cA + hstepA, voffA);
    if (wr == 1) PG8_BAR;
    PG8_WAIT_V(2); PG8_BAR;
    PG8_STAGE(PG8_SB(1, 0), cB + kstep, voffB); PG8_STAGE(PG8_SA(1, 0), cA + kstep, voffA); PG8_STAGE(PG8_SB(1, 1), cB + hstepB + kstep, voffB);
    PG8_WAIT_V(6); PG8_BAR;
    for (;;) {
        const bool has_next = PG8_NEXT(ui + 1, nxt);
        const char* nA = has_next ? (const char*)g.A + (size_t)nxt.pm * tstepA + (size_t)nxt.pn * g.apn + PG8_KOFF(ui + 1) : cA; const char* nB = has_next ? (const char*)g.Bt + (size_t)nxt.pn * tstepB + PG8_KOFF(ui + 1) : cB;
#pragma nounroll
        for (int t = 0; t < nt; t += 2) {
            const bool last = (t == nt - 2);
            const char* a1 = cA + (size_t)(t + 1) * kstep;
            const char* a2 = last ? nA : cA + (size_t)(t + 2) * kstep; const char* b2 = last ? nB : cB + (size_t)(t + 2) * kstep;
            const char* a3 = a2 + kstep; const char* b3 = b2 + kstep;
            PG8_LDB(B0, 0, 0); PG8_LDB(B1, 0, 1); PG8_SCHED; PG8_LDA(At, 0, 0); PG8_STAGE(PG8_SA(1, 1), a1 + hstepA, voffA);
            PG8_WAIT_V(8); PG8_WAIT_L(0); PG8_BAR; PG8_MMA(0, 0, At, B0); PG8_MMA(0, 1, At, B1); PG8_BAR; PG8_SCHED;
            PG8_LDA(At, 0, 1); PG8_STAGE(PG8_SB(0, 0), b2, voffB); PG8_STAGE(PG8_SB(0, 1), b2 + hstepB, voffB); PG8_STAGE(PG8_SA(0, 0), a2, voffA);
            PG8_WAIT_V(8); PG8_WAIT_L(0); PG8_BAR; PG8_MMA(1, 0, At, B0); PG8_MMA(1, 1, At, B1); PG8_BAR; PG8_SCHED;
            PG8_LDB(B0, 1, 0); PG8_LDB(B1, 1, 1); PG8_SCHED; PG8_LDA(At, 1, 0); PG8_STAGE(PG8_SA(0, 1), a2 + hstepA, voffA);
            PG8_WAIT_V(8); PG8_WAIT_L(0); PG8_BAR; PG8_MMA(0, 0, At, B0); PG8_MMA(0, 1, At, B1); PG8_BAR; PG8_SCHED;
            PG8_LDA(At, 1, 1); PG8_STAGE(PG8_SB(1, 0), b3, voffB); PG8_STAGE(PG8_SB(1, 1), b3 + hstepB, voffB); PG8_STAGE(PG8_SA(1, 0), a3, voffA);
            PG8_WAIT_V(8); PG8_WAIT_L(0); PG8_BAR; PG8_MMA(1, 0, At, B0); PG8_MMA(1, 1, At, B1); PG8_BAR; PG8_SCHED;
        }
        if (wr == 0) PG8_BAR;
        bool fin = true;
        if constexpr (Epi::MID) { if ((ui & 1) == 0) { E.mid(acc, cur, wr, wc, fr, fq); fin = false; } }
        if constexpr (!Epi::FUSED) { if (fin) E(acc, cur, wr, wc, fr, fq); }
        if (!has_next) break;
        if (fin) {
#pragma unroll
        for (int a = 0; a < 2; ++a)
#pragma unroll
            for (int b = 0; b < 2; ++b)
#pragma unroll
                for (int m = 0; m < 4; ++m)
#pragma unroll
                    for (int n = 0; n < 2; ++n) acc[a][b][m][n] = (f32x4){0.f, 0.f, 0.f, 0.f};
        }
        cur = nxt; cA = nA; cB = nB; ++ui;
        if (wr == 1) PG8_BAR;
    }
    PG8_WAIT_V(0);
    PG8_BAR;
    if constexpr (Epi::FUSED) E.fused(acc, cur, wr, wc, fr, fq, lds);
#undef PG8_NEXT
#undef PG8_KOFF
#undef PG8_SA
#undef PG8_SB
#undef PG8_STAGE
#undef PG8_LDA
#undef PG8_LDB
#undef PG8_MMA
#undef PG8_WAIT_V
#undef PG8_WAIT_L
#undef PG8_BAR
#undef PG8_SCHED
}

struct Epi1 {
    static constexpr bool PERM = true, MID = false, FUSED = false;
    bf16_t* H1; bf16_t* G; const float* cosT; const float* sinT;
    __device__ __forceinline__ void operator()(const Acc& acc, const Unit& u, int wr, int wc, int fr, int fq) const {
        const int row0 = u.pm * BM + wr * 64 + fr;
        if (u.pn < 8) {
            const float sc = (u.pn < 4) ? QSCALE : 1.0f;
            const int d0 = 16 * wc + 4 * fq;
#pragma unroll
            for (int ai = 0; ai < 2; ++ai)
#pragma unroll
                for (int m = 0; m < 4; ++m) { const int row = row0 + ai * HALF + m * 16;
                    const f32x4 cs = *(const f32x4*)(cosT + (size_t)row * 64 + d0) * sc, sn = *(const f32x4*)(sinT + (size_t)row * 64 + d0) * sc;
#pragma unroll
                    for (int bj = 0; bj < 2; ++bj) { const f32x4 v0 = acc[ai][bj][m][0], v1 = acc[ai][bj][m][1];
                        const f32x4 lo = v0 * cs - v1 * sn, hi = v1 * cs + v0 * sn;
                        bf16_t* p = H1 + (size_t)row * 4096 + u.pn * BM + bj * HALF + d0;
                        u32x2 a, b; a.x = cvt_pk_bf16(lo[0], lo[1]); a.y = cvt_pk_bf16(lo[2], lo[3]); b.x = cvt_pk_bf16(hi[0], hi[1]); b.y = cvt_pk_bf16(hi[2], hi[3]);
                        *(u32x2*)p = a; *(u32x2*)(p + 64) = b; } }
        } else if (u.pn < 16) {
            const int col0 = u.pn * BM + wc * 32 + 8 * fq;
#pragma unroll
            for (int ai = 0; ai < 2; ++ai)
#pragma unroll
                for (int m = 0; m < 4; ++m) { bf16_t* rowp = H1 + (size_t)(row0 + ai * HALF + m * 16) * 4096 + col0;
#pragma unroll
                    for (int bj = 0; bj < 2; ++bj) { const f32x4 v0 = acc[ai][bj][m][0], v1 = acc[ai][bj][m][1];
                        u32x4 w; w.x = cvt_pk_bf16(v0[0], v0[1]); w.y = cvt_pk_bf16(v0[2], v0[3]); w.z = cvt_pk_bf16(v1[0], v1[1]); w.w = cvt_pk_bf16(v1[2], v1[3]);
                        *(u32x4*)(rowp + bj * HALF) = w; } }
        } else {
            const int col0 = (u.pn - 16) * BM + wc * 32 + 8 * fq;
#pragma unroll
            for (int ai = 0; ai < 2; ++ai)
#pragma unroll
                for (int m = 0; m < 4; ++m) { bf16_t* rowp = G + (size_t)(row0 + ai * HALF + m * 16) * 4096 + col0;
#pragma unroll
                    for (int bj = 0; bj < 2; ++bj) { f32x4 v0 = acc[ai][bj][m][0], v1 = acc[ai][bj][m][1];
#pragma unroll
                        for (int j = 0; j < 4; ++j) { v0[j] = __builtin_amdgcn_rcpf(1.0f + __expf(-fmaxf(v0[j], -60.f))); v1[j] = __builtin_amdgcn_rcpf(1.0f + __expf(-fmaxf(v1[j], -60.f))); }
                        u32x4 w; w.x = cvt_pk_bf16(v0[0], v0[1]); w.y = cvt_pk_bf16(v0[2], v0[3]); w.z = cvt_pk_bf16(v1[0], v1[1]); w.w = cvt_pk_bf16(v1[2], v1[3]);
                        __builtin_nontemporal_store(w, (u32x4*)(rowp + bj * HALF)); } }
        }
    }
};
template <int ACT> struct EpiBf16 {
    static constexpr bool PERM = true, MID = false, FUSED = false;
    bf16_t* O; int ldc; int coloff; const float* scale;
    __device__ __forceinline__ void operator()(const Acc& acc, const Unit& u, int wr, int wc, int fr, int fq) const {
        const int row0 = u.pm * BM + wr * 64 + fr, col0 = u.pn * BM + wc * 32 + 8 * fq;
#pragma unroll
        for (int ai = 0; ai < 2; ++ai)
#pragma unroll
            for (int m = 0; m < 4; ++m) { bf16_t* rowp = O + (size_t)(row0 + ai * HALF + m * 16) * ldc + coloff + col0;
#pragma unroll
                for (int bj = 0; bj < 2; ++bj) { f32x4 v0 = acc[ai][bj][m][0], v1 = acc[ai][bj][m][1];
                    if (ACT == 1) {
#pragma unroll
                        for (int j = 0; j < 4; ++j) { const float a = fmaxf(v0[j], 0.f), b = fmaxf(v1[j], 0.f); v0[j] = a * a; v1[j] = b * b; } }
                    if (ACT == 2) { v0 = v0 * *(const f32x4*)(scale + col0 + bj * HALF); v1 = v1 * *(const f32x4*)(scale + col0 + bj * HALF + 4); }
                    u32x4 w; w.x = cvt_pk_bf16(v0[0], v0[1]); w.y = cvt_pk_bf16(v0[2], v0[3]); w.z = cvt_pk_bf16(v1[0], v1[1]); w.w = cvt_pk_bf16(v1[2], v1[3]);
                    *(u32x4*)(rowp + bj * HALF) = w; }
                if (ACT == 2) asm volatile("" ::: "memory"); }
    }
};
struct Epi3 {
    static constexpr bool PERM = true, MID = true, FUSED = false;
    bf16_t* O; const bf16_t* G;
    __device__ __forceinline__ void mid(Acc& acc, const Unit& u, int wr, int wc, int fr, int fq) const {
        const int row0 = u.pm * BM + wr * 64 + fr, col0 = u.pn * BM + wc * 32 + 8 * fq;
#pragma unroll
        for (int ai = 0; ai < 2; ++ai)
#pragma unroll
            for (int m = 0; m < 4; ++m) { const bf16_t* gp = G + (size_t)(row0 + ai * HALF + m * 16) * 4096 + col0;
#pragma unroll
                for (int bj = 0; bj < 2; ++bj) { const u32x4 a = __builtin_nontemporal_load((const u32x4*)(gp + bj * HALF)), b = *(const u32x4*)(gp + 2048 + bj * HALF);
                    f32x4 r0, r1;
                    r0[0] = bf_lo(a.x) * __builtin_amdgcn_rcpf(bf_lo(b.x)); r0[1] = bf_hi(a.x) * __builtin_amdgcn_rcpf(bf_hi(b.x)); r0[2] = bf_lo(a.y) * __builtin_amdgcn_rcpf(bf_lo(b.y)); r0[3] = bf_hi(a.y) * __builtin_amdgcn_rcpf(bf_hi(b.y));
                    r1[0] = bf_lo(a.z) * __builtin_amdgcn_rcpf(bf_lo(b.z)); r1[1] = bf_hi(a.z) * __builtin_amdgcn_rcpf(bf_hi(b.z)); r1[2] = bf_lo(a.w) * __builtin_amdgcn_rcpf(bf_lo(b.w)); r1[3] = bf_hi(a.w) * __builtin_amdgcn_rcpf(bf_hi(b.w));
                    acc[ai][bj][m][0] = acc[ai][bj][m][0] * r0; acc[ai][bj][m][1] = acc[ai][bj][m][1] * r1; }
                asm volatile("" ::: "memory"); }
    }
    __device__ __forceinline__ void operator()(const Acc& acc, const Unit& u, int wr, int wc, int fr, int fq) const {
        const int row0 = u.pm * BM + wr * 64 + fr, col0 = u.pn * BM + wc * 32 + 8 * fq;
#pragma unroll
        for (int ai = 0; ai < 2; ++ai)
#pragma unroll
            for (int m = 0; m < 4; ++m) { const size_t row = (size_t)(row0 + ai * HALF + m * 16); const bf16_t* gp = G + row * 4096 + 2048 + col0; bf16_t* rowp = O + row * DM + col0;
#pragma unroll
                for (int bj = 0; bj < 2; ++bj) { const u32x4 b = __builtin_nontemporal_load((const u32x4*)(gp + bj * HALF)); const f32x4 v0 = acc[ai][bj][m][0], v1 = acc[ai][bj][m][1];
                    u32x4 w; w.x = cvt_pk_bf16(v0[0] * bf_lo(b.x), v0[1] * bf_hi(b.x)); w.y = cvt_pk_bf16(v0[2] * bf_lo(b.y), v0[3] * bf_hi(b.y));
                    w.z = cvt_pk_bf16(v1[0] * bf_lo(b.z), v1[1] * bf_hi(b.z)); w.w = cvt_pk_bf16(v1[2] * bf_lo(b.w), v1[3] * bf_hi(b.w));
                    *(u32x4*)(rowp + bj * HALF) = w; }
                asm volatile("" ::: "memory"); }
    }
};
struct EpiRes {
    static constexpr bool PERM = false, MID = false, FUSED = false;
    const float* base; float* out;
    __device__ __forceinline__ void operator()(const Acc& acc, const Unit& u, int wr, int wc, int fr, int fq) const {
        const int row0 = u.pm * BM + wr * 64 + fr, col0 = u.pn * BM + wc * 32 + 4 * fq;
#pragma unroll
        for (int ai = 0; ai < 2; ++ai)
#pragma unroll
            for (int m = 0; m < 4; ++m) { const size_t off = (size_t)(row0 + ai * HALF + m * 16) * DM + col0;
#pragma unroll
                for (int bj = 0; bj < 2; ++bj)
#pragma unroll
                    for (int n = 0; n < 2; ++n) { const f32x4 bs = *(const f32x4*)(base + off + bj * HALF + n * 16); *(f32x4*)(out + off + bj * HALF + n * 16) = bs * ALPHA + acc[ai][bj][m][n]; } }
    }
};
template <bool BASE_BF16> struct EpiResLn {
    static constexpr bool PERM = false, MID = false, FUSED = true;
    const float* base; const bf16_t* baseb; float* out; bf16_t* xb; const float* gam; const float* bet; float* stats; unsigned* cnt;
    __device__ __forceinline__ void operator()(const Acc&, const Unit&, int, int, int, int) const {}
    __device__ __forceinline__ void fused(Acc& acc, const Unit& u, int wr, int wc, int fr, int fq, LAS unsigned char* lds) const {
        const int row0 = u.pm * BM + wr * 64 + fr, col0 = u.pn * BM + wc * 32 + 4 * fq;
        LAS float* Pst = (LAS float*)lds;
#pragma unroll
        for (int ai = 0; ai < 2; ++ai)
#pragma unroll
            for (int m = 0; m < 4; ++m) { const size_t off = (size_t)(row0 + ai * HALF + m * 16) * DM + col0; float s = 0.f, q = 0.f;
#pragma unroll
                for (int bj = 0; bj < 2; ++bj)
#pragma unroll
                    for (int n = 0; n < 2; ++n) { f32x4 bs; if (BASE_BF16) { const u32x2 wb = *(const u32x2*)(baseb + off + bj * HALF + n * 16); bs = (f32x4){bf_lo(wb.x), bf_hi(wb.x), bf_lo(wb.y), bf_hi(wb.y)}; } else bs = __builtin_nontemporal_load((const f32x4*)(base + off + bj * HALF + n * 16));
                        const f32x4 v = bs * ALPHA + acc[ai][bj][m][n]; acc[ai][bj][m][n] = v;
                        s += (v[0] + v[1]) + (v[2] + v[3]); q += (v[0] * v[0] + v[1] * v[1]) + (v[2] * v[2] + v[3] * v[3]); }
                s += __shfl_xor(s, 16); s += __shfl_xor(s, 32); q += __shfl_xor(q, 16); q += __shfl_xor(q, 32);
                if (fq == 0) { const int rl = ai * HALF + wr * 64 + m * 16 + fr; Pst[(rl * 4 + wc) * 2] = s; Pst[(rl * 4 + wc) * 2 + 1] = q; }
                asm volatile("" ::: "memory"); }
        __syncthreads();
        if (threadIdx.x < 256) { const int rl = threadIdx.x; float s = 0.f, q = 0.f;
#pragma unroll
            for (int w = 0; w < 4; ++w) { s += Pst[(rl * 4 + w) * 2]; q += Pst[(rl * 4 + w) * 2 + 1]; }
            unsigned long long* st = (unsigned long long*)stats + ((size_t)(u.pm * BM + rl) * 8 + u.pn);
            __hip_atomic_store(st, ((unsigned long long)__float_as_uint(q) << 32) | __float_as_uint(s), __ATOMIC_RELAXED, __HIP_MEMORY_SCOPE_AGENT); }
        asm volatile("s_waitcnt vmcnt(0)" ::: "memory");
        __syncthreads();
        if (threadIdx.x == 0) { unsigned* c = cnt + 64 * u.pm; (void)xb_add(c, 1u); unsigned sp = 0u;
            while (xb_ld(c) < 8u) { __builtin_amdgcn_s_sleep(1); if (++sp > XB_SPIN_CAP) break; } }
        __syncthreads();
        LAS float* Sst = (LAS float*)(lds + 8192);
        if (threadIdx.x < 256) { const int rl = threadIdx.x; const unsigned long long* st = (const unsigned long long*)stats + (size_t)(u.pm * BM + rl) * 8; float s = 0.f, q = 0.f;
#pragma unroll
            for (int t = 0; t < 8; ++t) { const unsigned long long v = __hip_atomic_load(st + t, __ATOMIC_RELAXED, __HIP_MEMORY_SCOPE_AGENT); s += __uint_as_float((unsigned)v); q += __uint_as_float((unsigned)(v >> 32)); }
            const float mean = s * (1.0f / DM); const float var = fmaxf(q * (1.0f / DM) - mean * mean, 0.f);
            Sst[rl * 2] = mean; Sst[rl * 2 + 1] = 1.0f / sqrtf(var + LN_EPS); }
        __syncthreads();
#pragma unroll
        for (int ai = 0; ai < 2; ++ai)
#pragma unroll
            for (int m = 0; m < 4; ++m) { const int row = row0 + ai * HALF + m * 16; const size_t off = (size_t)row * DM + col0;
                const int rl = ai * HALF + wr * 64 + m * 16 + fr; const float mean = Sst[rl * 2], rstd = Sst[rl * 2 + 1];
#pragma unroll
                for (int bj = 0; bj < 2; ++bj)
#pragma unroll
                    for (int n = 0; n < 2; ++n) { const int c = col0 + bj * HALF + n * 16; const f32x4 gg = *(const f32x4*)(gam + c), bb = *(const f32x4*)(bet + c);
                        const f32x4 y = (acc[ai][bj][m][n] - mean) * rstd * gg + bb; if (out) __builtin_nontemporal_store(y, (f32x4*)(out + off + bj * HALF + n * 16));
                        if (xb) { u32x2 wv; wv.x = cvt_pk_bf16(y[0], y[1]); wv.y = cvt_pk_bf16(y[2], y[3]); *(u32x2*)(xb + off + bj * HALF + n * 16) = wv; } }
                asm volatile("" ::: "memory"); }
    }
};
}

__device__ __forceinline__ int rope_permd(int d) { return 8 * ((d & 63) >> 2) + 4 * (d >> 6) + (d & 3); }
__device__ __forceinline__ void transpose_item(const float* W, int N, bf16_t* WT, int ldw, int coloff, int row_off, bool rope, LAS float* scr, int kb, int nb, int lane, const float* rscale = nullptr) {
    const int k0 = 64 * kb, n0 = 64 * nb;
    const int lk = lane >> 4, n4 = 4 * (lane & 15);
    f32x4 tv[16];
#pragma unroll
    for (int i = 0; i < 16; ++i) tv[i] = __builtin_nontemporal_load((const f32x4*)(W + (size_t)(k0 + 4 * i + lk) * N + n0 + n4));
#pragma unroll
    for (int i = 0; i < 16; ++i) { const int k = 4 * i + lk; *(LAS f32x4*)(scr + k * 64 + (n4 ^ (4 * (k >> 3)))) = tv[i]; }
    LDS_WAIT(); asm volatile("" ::: "memory");
    const int c = lane & 7;
#pragma unroll
    for (int j = 0; j < 8; ++j) { const int n = (lane >> 3) + 8 * j; const LAS float* s = scr + (8 * c) * 64 + (n ^ (4 * c));
        const float rs = rscale ? rscale[n0 + n] : 1.0f;
        u32x4 o; o.x = cvt_pk_bf16(s[0 * 64] * rs, s[1 * 64] * rs); o.y = cvt_pk_bf16(s[2 * 64] * rs, s[3 * 64] * rs); o.z = cvt_pk_bf16(s[4 * 64] * rs, s[5 * 64] * rs); o.w = cvt_pk_bf16(s[6 * 64] * rs, s[7 * 64] * rs);
        const int ncol = n0 + n; const int drow = (rope && ncol < 2048) ? ((ncol & ~127) + rope_permd(ncol & 127)) : ncol;
        *(u32x4*)(WT + (size_t)(row_off + drow) * ldw + coloff + k0 + 8 * c) = o; }
    LDS_WAIT(); asm volatile("" ::: "memory");
}

struct Ptrs {
    const float *x, *w_in, *w_pool, *pool_scale, *w_ba, *w_bb, *w_out, *ln1g, *ln1b, *w_ff1, *w_ff2, *ln2g, *ln2b; const int* pos;
    float* out; unsigned char* ws;
};

template <bool late> __device__ __forceinline__ void p0_prologue(const Ptrs& P, LAS unsigned char* lds, int G, int bid) {
    const int tid = threadIdx.x, lane = tid & 63, wave = __builtin_amdgcn_readfirstlane(tid >> 6);
    LAS float* scr = (LAS float*)(lds + wave * 16384);
    const int gw = bid * 8 + wave, NGW = G * 8;
    bf16_t* Bt1 = (bf16_t*)(P.ws + WS_BT1); bf16_t* Bt3 = (bf16_t*)(P.ws + WS_BT3); bf16_t* Bt4 = (bf16_t*)(P.ws + WS_BT4); bf16_t* Bt5 = (bf16_t*)(P.ws + WS_BT5); bf16_t* Bt6 = (bf16_t*)(P.ws + WS_BT6); bf16_t* WpT = (bf16_t*)(P.ws + WS_WPT);
    constexpr int I_IN = (DM / 64) * (IW / 64), I_PL = 4 * (256 / 64) * (256 / 64), I_BA = (AW / 64) * (DM / 64), I_OUT = (DM / 64) * (DM / 64), I_F1 = (DM / 64) * (FF / 64), I_F2 = (FF / 64) * (DM / 64);
    constexpr int NITEMS = late ? (2 * I_BA + I_OUT + I_F1 + I_F2) : (I_IN + I_PL);
    for (int it = gw; it < NITEMS; it += NGW) {
        int r = it;
        if (late) {
            if (r < I_BA) { transpose_item(P.w_ba, DM, Bt3, 2048, 0, 0, false, scr, r / (DM / 64), r % (DM / 64), lane); continue; } r -= I_BA;
            if (r < I_BA) { transpose_item(P.w_bb, DM, Bt3, 2048, 1024, 0, false, scr, r / (DM / 64), r % (DM / 64), lane); continue; } r -= I_BA;
            if (r < I_OUT) { transpose_item(P.w_out, DM, Bt4, DM, 0, 0, false, scr, r / (DM / 64), r % (DM / 64), lane); continue; } r -= I_OUT;
            if (r < I_F1) { transpose_item(P.w_ff1, FF, Bt5, DM, 0, 0, false, scr, r / (FF / 64), r % (FF / 64), lane); continue; } r -= I_F1;
            transpose_item(P.w_ff2, DM, Bt6, FFP, 0, 0, false, scr, r / (DM / 64), r % (DM / 64), lane); continue; }
        if (r < I_IN) { transpose_item(P.w_in, IW, Bt1, DM, 0, 0, true, scr, r / (IW / 64), r % (IW / 64), lane); continue; } r -= I_IN;
        { const int g = r / 16, q = r % 16; transpose_item(P.w_pool + (size_t)g * 65536, 256, WpT, 256, 0, g * 256, false, scr, q / 4, q % 4, lane, P.pool_scale + g * 256); }
    }
    if (late) return;
    const int gt = bid * 512 + tid, NGT = G * 512;
    bf16_t* xb = (bf16_t*)(P.ws + WS_XB);
    for (int i = gt; i < S * DM / 8; i += NGT) { const f32x4 a = __builtin_nontemporal_load((const f32x4*)(P.x + (size_t)i * 8)), b = __builtin_nontemporal_load((const f32x4*)(P.x + (size_t)i * 8 + 4));
        u32x4 w; w.x = cvt_pk_bf16(a[0], a[1]); w.y = cvt_pk_bf16(a[2], a[3]); w.z = cvt_pk_bf16(b[0], b[1]); w.w = cvt_pk_bf16(b[2], b[3]); *(u32x4*)(xb + (size_t)i * 8) = w; }
    float* cosT = (float*)(P.ws + WS_COS); float* sinT = (float*)(P.ws + WS_SIN);
    const double invf_rev = exp(-(double)(gt & 63) * (9.210340371976184 / 64.0)) * 0.15915494309189535;
    for (int i = gt; i < S * 64; i += NGT) { const int t = i >> 6, f = i & 63;
        const double invf = (NGT & 63) ? exp(-(double)f * (9.210340371976184 / 64.0)) * 0.15915494309189535 : invf_rev; const double rev = (double)P.pos[t] * invf; const float fr = (float)(rev - floor(rev));
        cosT[i] = __builtin_amdgcn_cosf(fr); sinT[i] = __builtin_amdgcn_sinf(fr); }
}

__device__ __forceinline__ unsigned off_k(unsigned row, unsigned ch) { return 256u * row + 16u * (ch ^ (row & 15u)); }
__device__ __forceinline__ unsigned off_v(unsigned row, unsigned ch) { return 256u * row + 16u * (ch ^ ((row & 7u) << 1)); }
#define VTR(dst, addr, imm) asm volatile("ds_read_b64_tr_b16 %0, %1 offset:%c2" : "=&v"(dst) : "v"(addr), "i"(imm) : "memory")

__device__ __forceinline__ void attn_phase(const Ptrs& P, LAS unsigned char* lds, int G, int bid) {
    const int tid = threadIdx.x, lane = tid & 63, w = __builtin_amdgcn_readfirstlane(tid >> 6), ql = lane & 15, g = lane >> 4;
    const bf16_t* H1 = (const bf16_t*)(P.ws + WS_H1);
    bf16_t* OP = (bf16_t*)(P.ws + WS_OP); float* LSE = (float*)(P.ws + WS_LSE);
    LAS unsigned char* Ks = lds; LAS unsigned char* Vs = lds + 65536;
    const unsigned vbase = (unsigned)(size_t)Vs;
    const int srow = tid >> 4, sch = tid & 15;
    const unsigned soffK = off_k((unsigned)srow, (unsigned)sch), soffV = off_v((unsigned)srow, (unsigned)sch);
    unsigned vb[8];
    { const unsigned q4 = (unsigned)(lane & 15) >> 2, p4 = (unsigned)lane & 3;
#pragma unroll
      for (int c = 0; c < 8; ++c) vb[c] = vbase + off_v(16u * (unsigned)w + 4u * (unsigned)g + q4, 2u * c + (p4 >> 1)) + 8u * (p4 & 1u); }
#define ATT_DECODE(u_, p_, h_, r_, n_, dil_) const int p_ = (u_) >> 9, h_ = ((u_) & 511) >> 6; const int dil_ = 1 << (2 * p_); const int r_ = ((u_) & 63) >> (6 - 2 * p_), n_ = ((u_) & 63) & ((64 >> (2 * p_)) - 1)
    u32x4 kreg[8], vreg[8];
#define ATT_LOAD_TILE(dst, coloff, n_, dil_, r_, h_) do { _Pragma("unroll") for (int i = 0; i < 8; ++i) { dst[i] = (u32x4){0u, 0u, 0u, 0u}; \
        if (!((n_) == 0 && i < 4)) dst[i] = *(const u32x4*)(H1 + (size_t)((128 * ((n_) - 1) + srow + 32 * i) * (dil_) + (r_)) * 4096 + (coloff) + (h_) * 128 + sch * 8); } } while (0)
    { ATT_DECODE(bid, p, h, r, n, dil);
      if (bid < 3 * 512) { ATT_LOAD_TILE(kreg, 1024, n, dil, r, h); ATT_LOAD_TILE(vreg, 2048, n, dil, r, h); } }
    for (int u = bid; u < 3 * 512; u += G) {
        ATT_DECODE(u, p, h, r, n, dil);
#pragma unroll
        for (int i = 0; i < 8; ++i) *(LAS u32x4*)(Ks + soffK + 8192 * i) = kreg[i];
        const bool has_next = (u + G < 3 * 512);
        ATT_DECODE(u + G, p2, h2, r2, n2, dil2);
        if (has_next) ATT_LOAD_TILE(kreg, 1024, n2, dil2, r2, h2);
        const int qpos = (128 * n + 16 * w + ql) * dil + r;
        bf16x8 qf[4];
#pragma unroll
        for (int ks = 0; ks < 4; ++ks) qf[ks] = *(const bf16x8*)(H1 + (size_t)qpos * 4096 + h * 128 + 32 * ks + 8 * g);
        __syncthreads();
        f32x4 s[9];
#pragma unroll
        for (int t = 0; t < 9; ++t) { s[t] = (f32x4){0.f, 0.f, 0.f, 0.f};
#pragma unroll
            for (int ks = 0; ks < 4; ++ks) { const bf16x8 kf = *(const LAS bf16x8*)(Ks + off_k(16 * (w + t) + ql, 4 * ks + g)); s[t] = __builtin_amdgcn_mfma_f32_16x16x32_bf16(kf, qf[ks], s[t], 0, 0, 0); } }
        const float NEG = -INFINITY;
#pragma unroll
        for (int j = 0; j < 4; ++j) { const int kk = 4 * g + j; if (kk < ql) s[0][j] = NEG; if (kk > ql) s[8][j] = NEG; }
        if (n == 0) {
#pragma unroll
            for (int t = 0; t < 8; ++t) if (w + t < 8) s[t] = (f32x4){NEG, NEG, NEG, NEG}; }
        float mx = NEG;
#pragma unroll
        for (int t = 0; t < 9; ++t) mx = fmaxf(mx, fmaxf(fmaxf(s[t][0], s[t][1]), fmaxf(s[t][2], s[t][3])));
        mx = fmaxf(mx, __shfl_xor(mx, 16)); mx = fmaxf(mx, __shfl_xor(mx, 32));
        float l = 0.f;
#pragma unroll
        for (int t = 0; t < 9; ++t) {
#pragma unroll
            for (int j = 0; j < 4; ++j) { const float e = __builtin_amdgcn_exp2f(s[t][j] - mx); s[t][j] = e; l += e; } }
        l += __shfl_xor(l, 16); l += __shfl_xor(l, 32);
#pragma unroll
        for (int i = 0; i < 8; ++i) *(LAS u32x4*)(Vs + soffV + 8192 * i) = vreg[i];
        __syncthreads();
        f32x4 o[8];
#pragma unroll
        for (int c = 0; c < 8; ++c) o[c] = (f32x4){0.f, 0.f, 0.f, 0.f};
#pragma unroll
        for (int kp = 0; kp < 5; ++kp) { const int t0 = 2 * kp, t1 = (2 * kp + 1 < 9) ? 2 * kp + 1 : 2 * kp;
            bf16x8 pf; { const unsigned a = cvt_pk_bf16(s[t0][0], s[t0][1]), b = cvt_pk_bf16(s[t0][2], s[t0][3]);
                unsigned c2 = 0u, d2 = 0u; if (2 * kp + 1 < 9) { c2 = cvt_pk_bf16(s[t1][0], s[t1][1]); d2 = cvt_pk_bf16(s[t1][2], s[t1][3]); }
                const u32x4 pw = (u32x4){a, b, c2, d2}; pf = __builtin_bit_cast(bf16x8, pw); }
            s16x4 lo[8], hi[8];
#pragma unroll
            for (int c = 0; c < 8; ++c) { VTR(lo[c], vb[c], 4096 * t0); VTR(hi[c], vb[c], 4096 * t1); }
            LDS_WAIT(); __builtin_amdgcn_sched_barrier(0);
#pragma unroll
            for (int c = 0; c < 8; ++c) { const bf16x8 vf = (bf16x8){lo[c][0], lo[c][1], lo[c][2], lo[c][3], hi[c][0], hi[c][1], hi[c][2], hi[c][3]};
                o[c] = __builtin_amdgcn_mfma_f32_16x16x32_bf16(vf, pf, o[c], 0, 0, 0); }
        }
        if (has_next) ATT_LOAD_TILE(vreg, 2048, n2, dil2, r2, h2);
        const float inv = 1.0f / l;
        LAS unsigned char* ost = lds + OST_OFF + w * 2304;
        const int orow = lane >> 2, oseg = lane & 3;
        bf16_t* op = OP + (size_t)p * S * AW + (size_t)((128 * n + 16 * w + orow) * dil + r) * AW + h * 128 + 16 * oseg;
#pragma unroll
        for (int hf = 0; hf < 2; ++hf) {
#pragma unroll
            for (int cc = 0; cc < 4; ++cc) { const int c = 4 * hf + cc; u32x2 wv; wv.x = cvt_pk_bf16(o[c][0] * inv, o[c][1] * inv); wv.y = cvt_pk_bf16(o[c][2] * inv, o[c][3] * inv);
                *(LAS u32x2*)(ost + ql * 144 + cc * 32 + g * 8) = wv; }
            asm volatile("" ::: "memory");
            const u32x4 r0 = *(const LAS u32x4*)(ost + orow * 144 + oseg * 32), r1 = *(const LAS u32x4*)(ost + orow * 144 + oseg * 32 + 16);
            asm volatile("" ::: "memory");
            *(u32x4*)(op + 64 * hf) = r0; *(u32x4*)(op + 64 * hf + 8) = r1;
        }
        if (g == 0) LSE[((size_t)p * S + qpos) * NH + h] = mx + __builtin_amdgcn_logf(l);
    }
    __syncthreads();
    bf16_t* Pp = (bf16_t*)(P.ws + WS_P);
    const int gt = bid * 512 + tid, NGT = G * 512;
    for (int i = gt; i < (S / 32) * 128; i += NGT) { const int ch = i & 127, t0 = (i >> 7) * 32; const int win = 2 << (ch >> 5);
        const bf16_t* src = H1 + (size_t)t0 * 4096 + 3072 + ch * 8;
        float ws8[8];
#pragma unroll
        for (int e = 0; e < 8; ++e) ws8[e] = 0.f;
        for (int j = 1; j <= win; ++j) if (t0 - j >= 0) { const u32x4 y = *(const u32x4*)(src - (size_t)j * 4096);
            ws8[0] += bf_lo(y.x); ws8[1] += bf_hi(y.x); ws8[2] += bf_lo(y.y); ws8[3] += bf_hi(y.y); ws8[4] += bf_lo(y.z); ws8[5] += bf_hi(y.z); ws8[6] += bf_lo(y.w); ws8[7] += bf_hi(y.w); }
#pragma unroll 8
        for (int s = 0; s < 32; ++s) { const int t = t0 + s; const u32x4 x0 = *(const u32x4*)(src + (size_t)s * 4096);
            u32x4 y = (u32x4){0u, 0u, 0u, 0u}; if (t - win >= 0) y = *(const u32x4*)(src + (size_t)(s - win) * 4096);
            const float xs[8] = {bf_lo(x0.x), bf_hi(x0.x), bf_lo(x0.y), bf_hi(x0.y), bf_lo(x0.z), bf_hi(x0.z), bf_lo(x0.w), bf_hi(x0.w)};
            const float ys[8] = {bf_lo(y.x), bf_hi(y.x), bf_lo(y.y), bf_hi(y.y), bf_lo(y.z), bf_hi(y.z), bf_lo(y.w), bf_hi(y.w)};
            const int cnt = (t + 1 < win) ? t + 1 : win; const float ic = 1.0f / (float)cnt;
            float pv[8];
#pragma unroll
            for (int e = 0; e < 8; ++e) { ws8[e] += xs[e] - ys[e]; pv[e] = ws8[e] * ic - xs[e]; }
            u32x4 wv; wv.x = cvt_pk_bf16(pv[0], pv[1]); wv.y = cvt_pk_bf16(pv[2], pv[3]); wv.z = cvt_pk_bf16(pv[4], pv[5]); wv.w = cvt_pk_bf16(pv[6], pv[7]);
            *(u32x4*)(Pp + (size_t)t * AW + ch * 8) = wv; }
    }
}

__device__ __forceinline__ void combine_phase(const Ptrs& P, int G, int bid) {
    const bf16_t* OP = (const bf16_t*)(P.ws + WS_OP); const float* LSE = (const float*)(P.ws + WS_LSE); bf16_t* A3 = (bf16_t*)(P.ws + WS_A3);
    int start, cnt;
    if (G == 256) { start = (bid < 128) ? bid * 2048 : 128 * 2048 + (bid - 128) * 6144; cnt = (bid < 128) ? 2048 : 6144; }
    else { const int per = (S * 128 + G - 1) / G; start = bid * per; cnt = (start + per <= S * 128) ? per : (S * 128 > start ? S * 128 - start : 0); }
    for (int b0 = threadIdx.x; b0 < cnt; b0 += 4 * 512) {
        u32x4 a[4], b[4], c[4]; float l0[4], l1[4], l2[4];
#pragma unroll
        for (int k = 0; k < 4; ++k) { const int ii = b0 + 512 * k; const int i = start + (ii < cnt ? ii : b0); const int t = i >> 7, ch = i & 127, h = ch >> 4;
            l0[k] = LSE[((size_t)0 * S + t) * NH + h]; l1[k] = LSE[((size_t)1 * S + t) * NH + h]; l2[k] = LSE[((size_t)2 * S + t) * NH + h];
            const size_t off = (size_t)t * AW + ch * 8;
            a[k] = __builtin_nontemporal_load((const u32x4*)(OP + off)); b[k] = __builtin_nontemporal_load((const u32x4*)(OP + (size_t)S * AW + off)); c[k] = __builtin_nontemporal_load((const u32x4*)(OP + 2 * (size_t)S * AW + off)); }
#pragma unroll
        for (int k = 0; k < 4; ++k) { const int ii = b0 + 512 * k; if (ii < cnt) { const int i = start + ii; const int t = i >> 7, ch = i & 127;
            const float m = fmaxf(l0[k], fmaxf(l1[k], l2[k])); float w0 = __builtin_amdgcn_exp2f(l0[k] - m), w1 = __builtin_amdgcn_exp2f(l1[k] - m), w2 = __builtin_amdgcn_exp2f(l2[k] - m);
            const float is = 1.0f / (w0 + w1 + w2); w0 *= is; w1 *= is; w2 *= is;
            u32x4 wv;
            wv.x = cvt_pk_bf16(w0 * bf_lo(a[k].x) + w1 * bf_lo(b[k].x) + w2 * bf_lo(c[k].x), w0 * bf_hi(a[k].x) + w1 * bf_hi(b[k].x) + w2 * bf_hi(c[k].x));
            wv.y = cvt_pk_bf16(w0 * bf_lo(a[k].y) + w1 * bf_lo(b[k].y) + w2 * bf_lo(c[k].y), w0 * bf_hi(a[k].y) + w1 * bf_hi(b[k].y) + w2 * bf_hi(c[k].y));
            wv.z = cvt_pk_bf16(w0 * bf_lo(a[k].z) + w1 * bf_lo(b[k].z) + w2 * bf_lo(c[k].z), w0 * bf_hi(a[k].z) + w1 * bf_hi(b[k].z) + w2 * bf_hi(c[k].z));
            wv.w = cvt_pk_bf16(w0 * bf_lo(a[k].w) + w1 * bf_lo(b[k].w) + w2 * bf_lo(c[k].w), w0 * bf_hi(a[k].w) + w1 * bf_hi(b[k].w) + w2 * bf_hi(c[k].w));
            *(u32x4*)(A3 + (size_t)t * DM + ch * 8) = wv; } }
    }
}

__device__ __forceinline__ float wave_sum(float v) {
#pragma unroll
    for (int o = 1; o < 64; o <<= 1) v += __shfl_xor(v, o);
    return v;
}
__device__ __forceinline__ void ln_phase(float* X, const float* gam, const float* bet, bf16_t* xb, int G, int bid) {
    const int lane = threadIdx.x & 63, wave = threadIdx.x >> 6; const int gw = bid * 8 + wave, NGW = G * 8;
    for (int row = gw; row < S; row += NGW) { f32x4* xr = (f32x4*)(X + (size_t)row * DM) + lane;
        f32x4 v[8]; float s = 0.f;
#pragma unroll
        for (int j = 0; j < 8; ++j) { v[j] = xr[64 * j]; s += (v[j][0] + v[j][1]) + (v[j][2] + v[j][3]); }
        const float mean = wave_sum(s) * (1.0f / DM); float s2 = 0.f;
#pragma unroll
        for (int j = 0; j < 8; ++j) { v[j] = v[j] - mean; s2 += (v[j][0] * v[j][0] + v[j][1] * v[j][1]) + (v[j][2] * v[j][2] + v[j][3] * v[j][3]); }
        const float rstd = 1.0f / sqrtf(wave_sum(s2) * (1.0f / DM) + LN_EPS);
#pragma unroll
        for (int j = 0; j < 8; ++j) { const f32x4 gg = *((const f32x4*)gam + lane + 64 * j), bb = *((const f32x4*)bet + lane + 64 * j); const f32x4 y = v[j] * rstd * gg + bb; xr[64 * j] = y;
            if (xb) { u32x2 wv; wv.x = cvt_pk_bf16(y[0], y[1]); wv.y = cvt_pk_bf16(y[2], y[3]); *((u32x2*)(xb + (size_t)row * DM) + lane + 64 * j) = wv; } }
    }
}

struct Args { const void* in[14]; float* out; unsigned char* ws; int ph_lo, ph_hi; };
__global__ void __launch_bounds__(512, 2) mega_fwd(Args a) {
    extern __shared__ __attribute__((aligned(16))) unsigned char lds_raw[];
    LAS unsigned char* lds = (LAS unsigned char*)lds_raw;
    Ptrs P;
    P.x = (const float*)a.in[0]; P.pos = (const int*)a.in[1]; P.w_in = (const float*)a.in[2]; P.w_pool = (const float*)a.in[3]; P.pool_scale = (const float*)a.in[4];
    P.w_ba = (const float*)a.in[5]; P.w_bb = (const float*)a.in[6]; P.w_out = (const float*)a.in[7]; P.ln1g = (const float*)a.in[8]; P.ln1b = (const float*)a.in[9];
    P.w_ff1 = (const float*)a.in[10]; P.w_ff2 = (const float*)a.in[11]; P.ln2g = (const float*)a.in[12]; P.ln2b = (const float*)a.in[13]; P.out = a.out; P.ws = a.ws;
    const int G = gridDim.x, bid = blockIdx.x;
    const int lo = a.ph_lo, hi = a.ph_hi;
    unsigned char* ws = a.ws;
#ifndef PHASE_MASK
#define PHASE_MASK 0x3ff
#endif
#define IN(k) (((PHASE_MASK >> (k)) & 1) && lo <= (k) && (k) < hi)
    volatile LAS unsigned* bst = (volatile LAS unsigned*)(lds + 131072 + 64);
    if (threadIdx.x < 2) bst[threadIdx.x] = 0u;
    __syncthreads();
    XcdBarrier xbar; xbar.bar = (unsigned*)ws; xbar.x = 0; xbar.st = bst;
    xbar = xcd_barrier_post((unsigned*)ws, bst);
#define SEAM(k) do { if (IN(k) && IN((k) + 1)) { if (hi > NPH) cg::this_grid().sync();   else xcd_barrier(xbar); } } while (0)
#ifndef REP_MASK
#define REP_MASK 0
#endif
    if (IN(0)) { p0_prologue<false>(P, lds, G, bid); __syncthreads(); }
    SEAM(0);
    if (REP_MASK & 1024) { xcd_barrier(xbar); xcd_barrier(xbar); xcd_barrier(xbar); xcd_barrier(xbar); }
    if (IN(1)) {
        pg8::Gemm g{(const bf16_t*)(ws + WS_XB), (const bf16_t*)(ws + WS_BT1), DM, DM, DM, 0}; pg8::StaticOrder so; so.init(S, IW, G, bid, 0);
        pg8::Epi1 E{(bf16_t*)(ws + WS_H1), (bf16_t*)(ws + WS_G), (const float*)(ws + WS_COS), (const float*)(ws + WS_SIN)};
        pg8::gemm_phase(lds, g, so, E);
        if (REP_MASK & 2) { __syncthreads(); pg8::gemm_phase(lds, g, so, E); }
    }
    SEAM(1);
    if (IN(2)) { const int vcu = (G % 8 == 0) ? (bid % 8) * (G / 8) + bid / 8 : bid;
        attn_phase(P, lds, G, vcu); if (REP_MASK & 4) { __syncthreads(); attn_phase(P, lds, G, vcu); } }
    SEAM(2);
    if (IN(3)) {
        pg8::Gemm g{(const bf16_t*)(ws + WS_P), (const bf16_t*)(ws + WS_WPT), AW, 256, 256, 512}; pg8::StaticOrder so; so.init(S, 1024, G, bid);
        pg8::EpiBf16<0> E{(bf16_t*)(ws + WS_A3), DM, 1024, nullptr};
        pg8::gemm_phase(lds, g, so, E);
        combine_phase(P, G, bid);
        p0_prologue<true>(P, lds, G, bid);
    }
    SEAM(3);
    if (IN(4)) {
        pg8::Gemm g{(const bf16_t*)(ws + WS_A3), (const bf16_t*)(ws + WS_BT3), DM, 2048, 1024  , 0}; pg8::StaticOrder so; so.init(S, DM, G, bid);
        pg8::Epi3 E{(bf16_t*)(ws + WS_MRG), (const bf16_t*)(ws + WS_G)};
        pg8::gemm_phase(lds, g, so, E);
        if (REP_MASK & 16) { __syncthreads(); pg8::gemm_phase(lds, g, so, E); }
    }
    SEAM(4);
    if (IN(5)) {
        pg8::Gemm g{(const bf16_t*)(ws + WS_MRG), (const bf16_t*)(ws + WS_BT4), DM, DM, DM, 0}; pg8::StaticOrder so; so.init(S, DM, G, bid);
        pg8::EpiResLn<false> E{P.x, nullptr, nullptr, (bf16_t*)(ws + WS_X1B), P.ln1g, P.ln1b, (float*)(ws + WS_ST1), (unsigned*)(ws + 16384)};
        pg8::gemm_phase(lds, g, so, E);
    }
    SEAM(5);
    if (IN(7)) {
        pg8::Gemm g{(const bf16_t*)(ws + WS_X1B), (const bf16_t*)(ws + WS_BT5), DM, DM, DM, 0}; pg8::StaticOrder so; so.init(S, FF, G, bid);
        pg8::EpiBf16<1> E{(bf16_t*)(ws + WS_ACT), FFP, 0, nullptr};
        pg8::gemm_phase(lds, g, so, E);
        if (REP_MASK & 128) { __syncthreads(); pg8::gemm_phase(lds, g, so, E); }
    }
    SEAM(7);
    if (IN(8)) {
        pg8::Gemm g{(const bf16_t*)(ws + WS_ACT), (const bf16_t*)(ws + WS_BT6), FFP, FFP, FF, 0}; pg8::StaticOrder so; so.init(S, DM, G, bid);

        pg8::EpiResLn<true> E{nullptr, (const bf16_t*)(ws + WS_X1B), P.out, nullptr, P.ln2g, P.ln2b, (float*)(ws + WS_ST2), (unsigned*)(ws + 24576)};
        pg8::gemm_phase(lds, g, so, E);
    }
#undef IN
#undef SEAM
}

#ifdef DBG_STOP
__global__ void dbg_dump(const bf16_t* src, float* out, int n) { for (int i = blockIdx.x * blockDim.x + threadIdx.x; i < n; i += gridDim.x * blockDim.x) out[i] = __builtin_bit_cast(float, (unsigned)src[i] << 16); }
#endif
extern "C" void kernel_launch(void* const* d_in, const int* in_sizes, int n_in, void* d_out, int out_size, void* d_ws, size_t ws_size, hipStream_t stream) {
    static int grid = 0;
    if (grid == 0) {
        if (n_in != 14 || out_size != S * DM || ws_size < WS_END) { fprintf(stderr, "kernel_launch: unexpected problem (n_in %d, out %d, ws %zu < %zu)\n", n_in, out_size, ws_size, (size_t)WS_END); grid = -1; return; }
        if (hipFuncSetAttribute((const void*)mega_fwd, hipFuncAttributeMaxDynamicSharedMemorySize, LDS_BYTES) != hipSuccess) { fprintf(stderr, "kernel_launch: hipFuncSetAttribute failed\n"); grid = -1; return; }
        int dev = 0, cus = 0, per_cu = 0;
        hipGetDevice(&dev); hipDeviceGetAttribute(&cus, hipDeviceAttributeMultiprocessorCount, dev);
        hipOccupancyMaxActiveBlocksPerMultiprocessor(&per_cu, (const void*)mega_fwd, 512, LDS_BYTES);
        if (per_cu < 1) { fprintf(stderr, "kernel_launch: occupancy query says %d blocks per CU\n", per_cu); per_cu = 1; }
        (void)hipGetLastError();
        grid = cus;
    }
    if (grid < 0) return;
    Args a{};
    for (int i = 0; i < 14; ++i) a.in[i] = d_in[i];
    a.out = (float*)d_out; a.ws = (unsigned char*)d_ws;
#if N_LAUNCH_MODE == 0
    if (hipMemsetAsync(d_ws, 0, WS_ZERO_BYTES, stream) != hipSuccess) { fprintf(stderr, "kernel_launch: memset of the barrier words failed\n"); return; }
    a.ph_lo = 0; a.ph_hi = NPH;
    void* args[] = {&a};
    hipError_t e = hipLaunchCooperativeKernel((const void*)mega_fwd, dim3(grid), dim3(512), args, LDS_BYTES, stream);
    if (e != hipSuccess) fprintf(stderr, "cooperative launch failed: %s (grid %d)\n", hipGetErrorString(e), grid);
#else
#ifdef DBG_STOP
    for (int ph = 0; ph <= DBG_STOP; ++ph) { a.ph_lo = ph; a.ph_hi = ph + 1; hipLaunchKernelGGL(mega_fwd, dim3(grid), dim3(512), LDS_BYTES, stream, a); }
    hipLaunchKernelGGL(dbg_dump, dim3(2048), dim3(256), 0, stream, (const bf16_t*)((unsigned char*)d_ws + (size_t)DBG_OFF * MiB), (float*)d_out, S * DM);
#else
    for (int ph = 0; ph < NPH; ++ph) { a.ph_lo = ph; a.ph_hi = ph + 1; hipLaunchKernelGGL(mega_fwd, dim3(grid), dim3(512), LDS_BYTES, stream, a); }
#endif
#endif
}
```

```cpp
#include <hip/hip_runtime.h>
#include <hip/hip_cooperative_groups.h>
#include <cstdio>
#include <cstdint>
namespace cg = cooperative_groups;

#ifndef N_LAUNCH_MODE
#define N_LAUNCH_MODE 0
#endif

#define LAS __attribute__((address_space(3)))
typedef unsigned short bf16_t;
typedef short bf16x8 __attribute__((ext_vector_type(8)));
typedef short s16x4 __attribute__((ext_vector_type(4)));
typedef float f32x4 __attribute__((ext_vector_type(4)));
typedef unsigned u32x4 __attribute__((ext_vector_type(4)));
typedef unsigned u32x2 __attribute__((ext_vector_type(2)));

constexpr int S = 8192, DM = 2048, IW = 8192, AW = 1024, FF = 8192, NH = 8;
constexpr float LN_EPS = 1e-5f;
constexpr float ALPHA = 1.189207115002721f;
constexpr float QSCALE = 0.08838834764831845f * 1.4426950408889634f;
constexpr int NPH = 10;

constexpr size_t MiB = 1u << 20;
constexpr size_t WS_ST1 = 65536, WS_ST2 = 82 * MiB + 524288  , WS_ZERO_BYTES = 32768;
static_assert(WS_ST1 + 524288 <= (1u << 20), "control MiB");
constexpr int FFP = FF + 64;
constexpr size_t WS_BT5 = 1 * MiB, WS_BT6 = 33 * MiB, WS_BT3 = 66 * MiB, WS_BT4 = 74 * MiB, WS_WPT = 82 * MiB, WS_COS = 83 * MiB, WS_SIN = 85 * MiB, WS_LSE = 87 * MiB;
constexpr size_t WS_X = 88 * MiB;
constexpr size_t WS_BT1 = WS_X, WS_XB = WS_X + 32 * MiB, WS_OP = WS_X, WS_P = WS_X + 48 * MiB, WS_MRG = WS_X, WS_X1B = WS_X;
constexpr size_t WS_H1 = 152 * MiB, WS_A3 = WS_H1, WS_G = 216 * MiB, WS_ACT = 152 * MiB, WS_END = 281 * MiB;
static_assert(WS_BT6 + (size_t)DM * FFP * 2 <= WS_BT3 && WS_ACT + (size_t)S * FFP * 2 <= WS_END, "workspace map");

constexpr int OST_OFF = 131072 + 1024;
constexpr int LDS_BYTES = OST_OFF + 8 * 2304;

typedef float f32x2_t __attribute__((ext_vector_type(2))); typedef __bf16 bf16x2_t __attribute__((ext_vector_type(2)));
__device__ __forceinline__ unsigned cvt_pk_bf16(float lo, float hi) { f32x2_t v = {lo, hi}; bf16x2_t b = __builtin_convertvector(v, bf16x2_t); return __builtin_bit_cast(unsigned, b); }
__device__ __forceinline__ float bf_lo(unsigned w) { return __builtin_bit_cast(float, w << 16); }
__device__ __forceinline__ float bf_hi(unsigned w) { return __builtin_bit_cast(float, w & 0xffff0000u); }
#define LDS_WAIT() asm volatile("s_waitcnt lgkmcnt(0)" ::: "memory")

#define XB_TMO      128
#define XB_XCNT(j)  (256  + 64 * (j))
#define XB_XSUB(j)  (1280 + 64 * (j))
#define XB_XGEN(j)  (2304 + 64 * (j))
#define XB_TOP      3328
#define XB_TOPGEN   3392
#define XCD_BAR_WORDS 3456
#define XB_SPIN_CAP (1u << 22)
__device__ __forceinline__ unsigned xb_ld(unsigned* p)              { return __hip_atomic_load(p, __ATOMIC_RELAXED, __HIP_MEMORY_SCOPE_AGENT); }
__device__ __forceinline__ unsigned xb_add(unsigned* p, unsigned v) { return __hip_atomic_fetch_add(p, v, __ATOMIC_RELAXED, __HIP_MEMORY_SCOPE_AGENT); }
__device__ __forceinline__ unsigned xb_xcc_id() { return (unsigned)__builtin_amdgcn_s_getreg((3 << 11) | 20) & 0xFu; }
#define XB_SPIN(cond, bar) do { unsigned _sp = 0; while (cond) { __builtin_amdgcn_s_sleep(1); \
    if ((++_sp & 255u) == 0u) { if (xb_ld(&(bar)[XB_TMO])) break; if (_sp > XB_SPIN_CAP) { atomicAdd(&(bar)[XB_TMO], 1u); break; } } } } while (0)
struct XcdBarrier { unsigned* bar; unsigned x; volatile LAS unsigned* st; };
__device__ __forceinline__ XcdBarrier xcd_barrier_post(unsigned* bar, volatile LAS unsigned* st) {
    XcdBarrier b; b.bar = bar; b.x = xb_xcc_id(); b.st = st;
    if (threadIdx.x == 0) (void)xb_add(&bar[XB_XCNT(b.x)], 1u);
    return b;
}
__device__ __forceinline__ void xcd_barrier_complete(unsigned* bar, unsigned x, unsigned& nloc, unsigned& nx) {
    const unsigned G = gridDim.x * gridDim.y * gridDim.z;
    unsigned sum, cnt, mine, sp = 0u;
    for (;;) {
        sum = 0u; cnt = 0u; mine = 0u;
#pragma unroll
        for (unsigned j = 0; j < 16; ++j) { const unsigned c = xb_ld(&bar[XB_XCNT(j)]); sum += c; cnt += (c > 0u) ? 1u : 0u; mine = (j == x) ? c : mine; }
        if (sum == G) break;
        __builtin_amdgcn_s_sleep(1);
        if ((++sp & 255u) == 0u) { if (xb_ld(&bar[XB_TMO])) break; if (sp > XB_SPIN_CAP) { atomicAdd(&bar[XB_TMO], 1u); break; } }
    }
    nloc = mine > 0u ? mine : 1u; nx = cnt > 0u ? cnt : 1u;
}
__device__ __forceinline__ void xcd_barrier(const XcdBarrier& b) {
    asm volatile("s_waitcnt vmcnt(0)" ::: "memory");
    __syncthreads();
    if (threadIdx.x == 0) {
        unsigned* bar = b.bar;
        __builtin_amdgcn_s_waitcnt(0);
        unsigned nloc = b.st[0], nx = b.st[1];
        if (nloc == 0u) { xcd_barrier_complete(bar, b.x, nloc, nx); b.st[0] = nloc; b.st[1] = nx; }
        const unsigned old = xb_add(&bar[XB_XSUB(b.x)], 1u);
        const unsigned gen = old / nloc;
        if (old + 1u == (gen + 1u) * nloc) {
            __builtin_amdgcn_fence(__ATOMIC_RELEASE, "agent");
            asm volatile("s_waitcnt vmcnt(0)" ::: "memory");
            const unsigned og = xb_add(&bar[XB_TOP], 1u);
            const unsigned tg = og / nx;
            if (og + 1u == (tg + 1u) * nx) xb_add(&bar[XB_TOPGEN], 1u);
            else XB_SPIN(xb_ld(&bar[XB_TOPGEN]) == tg, bar);
            __builtin_amdgcn_fence(__ATOMIC_ACQUIRE, "agent");
            xb_add(&bar[XB_XGEN(b.x)], 1u);
            asm volatile("s_waitcnt vmcnt(0)" ::: "memory");
        } else {
            XB_SPIN(xb_ld(&bar[XB_XGEN(b.x)]) == gen, bar);
            __builtin_amdgcn_fence(__ATOMIC_ACQUIRE, "agent");
            asm volatile("s_waitcnt vmcnt(0)" ::: "memory");
        }
    }
    __syncthreads();
}

namespace pg8 {
constexpr int BM = 256, BK = 64, HALF = 128, HTB = HALF * BK * 2, NXCD = 8, WGM = 4;
__host__ __device__ __forceinline__ int lds_byte(int r, int c) { const int st = (r >> 4) * 2 + (c >> 5), rr = r & 15, cc = c & 31, ob = rr * 64 + cc * 2; return st * 1024 + (ob ^ (((ob >> 9) & 1) << 5)); }
__host__ __device__ __forceinline__ void stage_rc(int b, int& R, int& C) { const int st = b / 1024, sb = b % 1024, swz = sb ^ (((sb >> 9) & 1) << 5); R = (st >> 1) * 16 + swz / 64; C = (st & 1) * 32 + (swz % 64) / 2; }
__host__ __device__ __forceinline__ int perm32(int rho) { const int n = rho >> 4, i = rho & 15; return 8 * (i >> 2) + 4 * n + (i & 3); }

struct Unit { int pm, pn; };
struct Gemm { const bf16_t* A; const bf16_t* Bt; int lda, ldb, K, apn; };

struct StaticOrder {
    int nM, nN, nwg, G, c, mix;
    __device__ void init(int M, int N, int G_, int c_, int mix_ = 0) { nM = M / BM; nN = N / BM; nwg = nM * nN; G = G_; c = c_; mix = mix_; }
    __device__ bool next(int i, Unit& u) const {
        const long L = (long)i * G + c; if (L >= nwg) return false;
        int wgid = (int)L; { const int q = nwg / NXCD, r = nwg % NXCD, xcd = wgid % NXCD, off = wgid / NXCD; wgid = (xcd < r ? xcd * (q + 1) : r * (q + 1) + (xcd - r) * q) + off; }
        const int nig = WGM * nN, gid = wgid / nig, fm = gid * WGM, gsz = (nM - fm) < WGM ? (nM - fm) : WGM;
        u.pm = fm + ((wgid % nig) % gsz); u.pn = (wgid % nig) / gsz;
        if (mix) { const int j = u.pn; u.pn = 16 * ((j >> 3) & 1) + 8 * ((j >> 4) & 1) + (j & 7); }
        return true;
    }
};

typedef f32x4 Acc[2][2][4][2];

template <class Epi>
__device__ __forceinline__ void gemm_phase(LAS unsigned char* lds, const Gemm g, const StaticOrder& S, const Epi& E) {
    const int tid = threadIdx.x, wid = __builtin_amdgcn_readfirstlane(tid >> 6), lane = tid & 63, wr = wid >> 2, wc = wid & 3, fr = lane & 15, fq = lane >> 4;
    const int K = g.K, nt = K / BK;
    unsigned voffA[2], voffB[2];
#pragma unroll
    for (int i = 0; i < 2; ++i) { int R, C; stage_rc(tid * 16 + i * 8192, R, C); const int Rb = Epi::PERM ? ((R & ~31) + perm32(R & 31)) : R;
        voffA[i] = (unsigned)(R * g.lda + C) * 2u; voffB[i] = (unsigned)(Rb * g.ldb + C) * 2u; }
    const size_t kstep = (size_t)(BK * 2);
    const size_t hstepA = (size_t)HALF * g.lda * 2, hstepB = (size_t)HALF * g.ldb * 2;
    const size_t tstepA = 2 * hstepA, tstepB = 2 * hstepB;
    const unsigned ldsw = (unsigned)wid * 1024u;
    const int aoff = lds_byte(wr * 64 + fr, fq * 8), boff = lds_byte(wc * 32 + fr, fq * 8);
#define PG8_SA(b, h) (((b) * 2 + (h)) * HTB)
#define PG8_SB(b, h) ((4 + (b) * 2 + (h)) * HTB)
#define PG8_STAGE(bufoff, gbase, voff) do { _Pragma("unroll") for (int _i = 0; _i < 2; ++_i) \
        __builtin_amdgcn_global_load_lds((const unsigned*)((const char*)(gbase) + (voff)[_i]), (LAS unsigned*)(lds + (bufoff) + ldsw + _i * 8192), 16, 0, 0); } while (0)
#define PG8_LDA(dst, b, h) do { _Pragma("unroll") for (int m = 0; m < 4; ++m) _Pragma("unroll") for (int k = 0; k < 2; ++k) dst[m][k] = *(const LAS bf16x8*)(lds + PG8_SA(b, h) + aoff + m * 2048 + k * 1024); } while (0)
#define PG8_LDB(dst, b, h) do { _Pragma("unroll") for (int n = 0; n < 2; ++n) _Pragma("unroll") for (int k = 0; k < 2; ++k) dst[n][k] = *(const LAS bf16x8*)(lds + PG8_SB(b, h) + boff + n * 2048 + k * 1024); } while (0)
#define PG8_MMA(ai, bj, At, Bt) do { __builtin_amdgcn_s_setprio(1); _Pragma("unroll") for (int m = 0; m < 4; ++m) _Pragma("unroll") for (int n = 0; n < 2; ++n) _Pragma("unroll") for (int k = 0; k < 2; ++k) \
        acc[ai][bj][m][n] = __builtin_amdgcn_mfma_f32_16x16x32_bf16(Bt[n][k], At[m][k], acc[ai][bj][m][n], 0, 0, 0); __builtin_amdgcn_s_setprio(0); } while (0)
#define PG8_WAIT_V(n) asm volatile("s_waitcnt vmcnt(" #n ")" ::: "memory")
#define PG8_WAIT_L(n) asm volatile("s_waitcnt lgkmcnt(" #n ")" ::: "memory")
#define PG8_BAR __builtin_amdgcn_s_barrier()
#define PG8_SCHED __builtin_amdgcn_sched_barrier(0)
    Unit cur, nxt; int ui = 0;
#define PG8_NEXT(i, u) (Epi::MID ? S.next((i) >> 1, u) : S.next((i), u))
#define PG8_KOFF(i) (Epi::MID ? (size_t)((i) & 1) * (size_t)K * 2 : (size_t)0)
    if (!PG8_NEXT(0, cur)) return;
    Acc acc;
#pragma unroll
    for (int a = 0; a < 2; ++a)
#pragma unroll
        for (int b = 0; b < 2; ++b)
#pragma unroll
            for (int m = 0; m < 4; ++m)
#pragma unroll
                for (int n = 0; n < 2; ++n) acc[a][b][m][n] = (f32x4){0.f, 0.f, 0.f, 0.f};
    bf16x8 At[4][2], B0[2][2], B1[2][2];
    const char* cA = (const char*)g.A + (size_t)cur.pm * tstepA + (size_t)cur.pn * g.apn + PG8_KOFF(0); const char* cB = (const char*)g.Bt + (size_t)cur.pn * tstepB + PG8_KOFF(0);
    PG8_STAGE(PG8_SB(0, 0), cB, voffB); PG8_STAGE(PG8_SB(0, 1), cB + hstepB, voffB); PG8_STAGE(PG8_SA(0, 0), cA, voffA); PG8_STAGE(PG8_SA(0, 1), cA + hstepA, voffA);
    if (wr == 1) PG8_BAR;
    PG8_WAIT_V(2); PG8_BAR;
    PG8_STAGE(PG8_SB(1, 0), cB + kstep, voffB); PG8_STAGE(PG8_SA(1, 0), cA + kstep, voffA); PG8_STAGE(PG8_SB(1, 1), cB + hstepB + kstep, voffB);
    PG8_WAIT_V(6); PG8_BAR;
    for (;;) {
        const bool has_next = PG8_NEXT(ui + 1, nxt);
        const char* nA = has_next ? (const char*)g.A + (size_t)nxt.pm * tstepA + (size_t)nxt.pn * g.apn + PG8_KOFF(ui + 1) : cA; const char* nB = has_next ? (const char*)g.Bt + (size_t)nxt.pn * tstepB + PG8_KOFF(ui + 1) : cB;
#pragma nounroll
        for (int t = 0; t < nt; t += 2) {
            const bool last = (t == nt - 2);
            const char* a1 = cA + (size_t)(t + 1) * kstep;
            const char* a2 = last ? nA : cA + (size_t)(t + 2) * kstep; const char* b2 = last ? nB : cB + (size_t)(t + 2) * kstep;
            const char* a3 = a2 + kstep; const char* b3 = b2 + kstep;
            PG8_LDB(B0, 0, 0); PG8_LDB(B1, 0, 1); PG8_SCHED; PG8_LDA(At, 0, 0); PG8_STAGE(PG8_SA(1, 1), a1 + hstepA, voffA);
            PG8_WAIT_V(8); PG8_WAIT_L(0); PG8_BAR; PG8_MMA(0, 0, At, B0); PG8_MMA(0, 1, At, B1); PG8_BAR; PG8_SCHED;
            PG8_LDA(At, 0, 1); PG8_STAGE(PG8_SB(0, 0), b2, voffB); PG8_STAGE(PG8_SB(0, 1), b2 + hstepB, voffB); PG8_STAGE(PG8_SA(0, 0), a2, voffA);
            PG8_WAIT_V(8); PG8_WAIT_L(0); PG8_BAR; PG8_MMA(1, 0, At, B0); PG8_MMA(1, 1, At, B1); PG8_BAR; PG8_SCHED;
            PG8_LDB(B0, 1, 0); PG8_LDB(B1, 1, 1); PG8_SCHED; PG8_LDA(At, 1, 0); PG8_STAGE(PG8_SA(0, 1), a2 + hstepA, voffA);
            PG8_WAIT_V(8); PG8_WAIT_L(0); PG8_BAR; PG8_MMA(0, 0, At, B0); PG8_MMA(0, 1, At, B1); PG8_BAR; PG8_SCHED;
            PG8_LDA(At, 1, 1); PG8_STAGE(PG8_SB(1, 0), b3, voffB); PG8_STAGE(PG8_SB(1, 1), b3 + hstepB, voffB); PG8_STAGE(PG8_SA(1, 0), a3, voffA);
            PG8_WAIT_V(8); PG8_WAIT_L(0); PG8_BAR; PG8_MMA(1, 0, At, B0); PG8_MMA(1, 1, At, B1); PG8_BAR; PG8_SCHED;
        }
        if constexpr (!Epi::MID) { if (wr == 0) PG8_BAR; }
        bool fin = true;
        if constexpr (Epi::MID) { if ((ui & 1) == 0) { E.mid(acc, cur, wr, wc, fr, fq); fin = false; } }
        if constexpr (!Epi::FUSED) { if (fin) E(acc, cur, wr, wc, fr, fq); }
        if (!has_next) break;
        if (fin) {
#pragma unroll
        for (int a = 0; a < 2; ++a)
#pragma unroll
            for (int b = 0; b < 2; ++b)
#pragma unroll
                for (int m = 0; m < 4; ++m)
#pragma unroll
                    for (int n = 0; n < 2; ++n) acc[a][b][m][n] = (f32x4){0.f, 0.f, 0.f, 0.f};
        }
        cur = nxt; cA = nA; cB = nB; ++ui;
        if constexpr (!Epi::MID) { if (wr == 1) PG8_BAR; }
    }
    PG8_WAIT_V(0);
    if constexpr (Epi::MID) { if (wr == 0) PG8_BAR; }
    PG8_BAR;
    if constexpr (Epi::FUSED) E.fused(acc, cur, wr, wc, fr, fq, lds);
#undef PG8_NEXT
#undef PG8_KOFF
#undef PG8_SA
#undef PG8_SB
#undef PG8_STAGE
#undef PG8_LDA
#undef PG8_LDB
#undef PG8_MMA
#undef PG8_WAIT_V
#undef PG8_WAIT_L
#undef PG8_BAR
#undef PG8_SCHED
}

struct Epi1 {
    static constexpr bool PERM = true, MID = false, FUSED = false;
    bf16_t* H1; bf16_t* G; const float* cosT; const float* sinT;
    __device__ __forceinline__ void operator()(const Acc& acc, const Unit& u, int wr, int wc, int fr, int fq) const {
        const int row0 = u.pm * BM + wr * 64 + fr;
        if (u.pn < 8) {
            const float sc = (u.pn < 4) ? QSCALE : 1.0f;
            const int d0 = 16 * wc + 4 * fq;
#pragma unroll
            for (int ai = 0; ai < 2; ++ai)
#pragma unroll
                for (int m = 0; m < 4; ++m) { const int row = row0 + ai * HALF + m * 16;
                    const f32x4 cs = *(const f32x4*)(cosT + (size_t)row * 64 + d0) * sc, sn = *(const f32x4*)(sinT + (size_t)row * 64 + d0) * sc;
#pragma unroll
                    for (int bj = 0; bj < 2; ++bj) { const f32x4 v0 = acc[ai][bj][m][0], v1 = acc[ai][bj][m][1];
                        const f32x4 lo = v0 * cs - v1 * sn, hi = v1 * cs + v0 * sn;
                        bf16_t* p = H1 + (size_t)row * 4096 + u.pn * BM + bj * HALF + d0;
                        u32x2 a, b; a.x = cvt_pk_bf16(lo[0], lo[1]); a.y = cvt_pk_bf16(lo[2], lo[3]); b.x = cvt_pk_bf16(hi[0], hi[1]); b.y = cvt_pk_bf16(hi[2], hi[3]);
                        *(u32x2*)p = a; *(u32x2*)(p + 64) = b; } }
        } else if (u.pn < 16) {
            const int col0 = u.pn * BM + wc * 32 + 8 * fq;
#pragma unroll
            for (int ai = 0; ai < 2; ++ai)
#pragma unroll
                for (int m = 0; m < 4; ++m) { bf16_t* rowp = H1 + (size_t)(row0 + ai * HALF + m * 16) * 4096 + col0;
#pragma unroll
                    for (int bj = 0; bj < 2; ++bj) { const f32x4 v0 = acc[ai][bj][m][0], v1 = acc[ai][bj][m][1];
                        u32x4 w; w.x = cvt_pk_bf16(v0[0], v0[1]); w.y = cvt_pk_bf16(v0[2], v0[3]); w.z = cvt_pk_bf16(v1[0], v1[1]); w.w = cvt_pk_bf16(v1[2], v1[3]);
                        *(u32x4*)(rowp + bj * HALF) = w; } }
        } else {
            const int col0 = (u.pn - 16) * BM + wc * 32 + 8 * fq;
#pragma unroll
            for (int ai = 0; ai < 2; ++ai)
#pragma unroll
                for (int m = 0; m < 4; ++m) { bf16_t* rowp = G + (size_t)(row0 + ai * HALF + m * 16) * 4096 + col0;
#pragma unroll
                    for (int bj = 0; bj < 2; ++bj) { f32x4 v0 = acc[ai][bj][m][0], v1 = acc[ai][bj][m][1];
#pragma unroll
                        for (int j = 0; j < 4; ++j) { v0[j] = __builtin_amdgcn_rcpf(1.0f + __expf(-fmaxf(v0[j], -60.f))); v1[j] = __builtin_amdgcn_rcpf(1.0f + __expf(-fmaxf(v1[j], -60.f))); }
                        u32x4 w; w.x = cvt_pk_bf16(v0[0], v0[1]); w.y = cvt_pk_bf16(v0[2], v0[3]); w.z = cvt_pk_bf16(v1[0], v1[1]); w.w = cvt_pk_bf16(v1[2], v1[3]);
                        __builtin_nontemporal_store(w, (u32x4*)(rowp + bj * HALF)); } }
        }
    }
};
template <int ACT> struct EpiBf16 {
    static constexpr bool PERM = true, MID = false, FUSED = false;
    bf16_t* O; int ldc; int coloff; const float* scale;
    __device__ __forceinline__ void operator()(const Acc& acc, const Unit& u, int wr, int wc, int fr, int fq) const {
        const int row0 = u.pm * BM + wr * 64 + fr, col0 = u.pn * BM + wc * 32 + 8 * fq;
#pragma unroll
        for (int ai = 0; ai < 2; ++ai)
#pragma unroll
            for (int m = 0; m < 4; ++m) { bf16_t* rowp = O + (size_t)(row0 + ai * HALF + m * 16) * ldc + coloff + col0;
#pragma unroll
                for (int bj = 0; bj < 2; ++bj) { f32x4 v0 = acc[ai][bj][m][0], v1 = acc[ai][bj][m][1];
                    if (ACT == 1) {
#pragma unroll
                        for (int j = 0; j < 4; ++j) { const float a = fmaxf(v0[j], 0.f), b = fmaxf(v1[j], 0.f); v0[j] = a * a; v1[j] = b * b; } }
                    if (ACT == 2) { v0 = v0 * *(const f32x4*)(scale + col0 + bj * HALF); v1 = v1 * *(const f32x4*)(scale + col0 + bj * HALF + 4); }
                    u32x4 w; w.x = cvt_pk_bf16(v0[0], v0[1]); w.y = cvt_pk_bf16(v0[2], v0[3]); w.z = cvt_pk_bf16(v1[0], v1[1]); w.w = cvt_pk_bf16(v1[2], v1[3]);
                    *(u32x4*)(rowp + bj * HALF) = w; }
                if (ACT == 2) asm volatile("" ::: "memory"); }
    }
};
struct Epi3 {
    static constexpr bool PERM = true, MID = true, FUSED = false;
    bf16_t* O; const bf16_t* G;
    __device__ __forceinline__ void mid(Acc& acc, const Unit& u, int wr, int wc, int fr, int fq) const {
        const int row0 = u.pm * BM + wr * 64 + fr, col0 = u.pn * BM + wc * 32 + 8 * fq;
#pragma unroll
        for (int ai = 0; ai < 2; ++ai)
#pragma unroll
            for (int m = 0; m < 4; ++m) { const bf16_t* gp = G + (size_t)(row0 + ai * HALF + m * 16) * 4096 + col0;
#pragma unroll
                for (int bj = 0; bj < 2; ++bj) { const u32x4 a = __builtin_nontemporal_load((const u32x4*)(gp + bj * HALF)), b = *(const u32x4*)(gp + 2048 + bj * HALF);
                    f32x4 r0, r1;
                    r0[0] = bf_lo(a.x) * __builtin_amdgcn_rcpf(bf_lo(b.x)); r0[1] = bf_hi(a.x) * __builtin_amdgcn_rcpf(bf_hi(b.x)); r0[2] = bf_lo(a.y) * __builtin_amdgcn_rcpf(bf_lo(b.y)); r0[3] = bf_hi(a.y) * __builtin_amdgcn_rcpf(bf_hi(b.y));
                    r1[0] = bf_lo(a.z) * __builtin_amdgcn_rcpf(bf_lo(b.z)); r1[1] = bf_hi(a.z) * __builtin_amdgcn_rcpf(bf_hi(b.z)); r1[2] = bf_lo(a.w) * __builtin_amdgcn_rcpf(bf_lo(b.w)); r1[3] = bf_hi(a.w) * __builtin_amdgcn_rcpf(bf_hi(b.w));
                    acc[ai][bj][m][0] = acc[ai][bj][m][0] * r0; acc[ai][bj][m][1] = acc[ai][bj][m][1] * r1; }
                asm volatile("" ::: "memory"); }
    }
    __device__ __forceinline__ void operator()(const Acc& acc, const Unit& u, int wr, int wc, int fr, int fq) const {
        const int row0 = u.pm * BM + wr * 64 + fr, col0 = u.pn * BM + wc * 32 + 8 * fq;
#pragma unroll
        for (int ai = 0; ai < 2; ++ai)
#pragma unroll
            for (int m = 0; m < 4; ++m) { const size_t row = (size_t)(row0 + ai * HALF + m * 16); const bf16_t* gp = G + row * 4096 + 2048 + col0; bf16_t* rowp = O + row * DM + col0;
#pragma unroll
                for (int bj = 0; bj < 2; ++bj) { const u32x4 b = __builtin_nontemporal_load((const u32x4*)(gp + bj * HALF)); const f32x4 v0 = acc[ai][bj][m][0], v1 = acc[ai][bj][m][1];
                    u32x4 w; w.x = cvt_pk_bf16(v0[0] * bf_lo(b.x), v0[1] * bf_hi(b.x)); w.y = cvt_pk_bf16(v0[2] * bf_lo(b.y), v0[3] * bf_hi(b.y));
                    w.z = cvt_pk_bf16(v1[0] * bf_lo(b.z), v1[1] * bf_hi(b.z)); w.w = cvt_pk_bf16(v1[2] * bf_lo(b.w), v1[3] * bf_hi(b.w));
                    *(u32x4*)(rowp + bj * HALF) = w; }
                asm volatile("" ::: "memory"); }
    }
};
struct EpiRes {
    static constexpr bool PERM = false, MID = false, FUSED = false;
    const float* base; float* out;
    __device__ __forceinline__ void operator()(const Acc& acc, const Unit& u, int wr, int wc, int fr, int fq) const {
        const int row0 = u.pm * BM + wr * 64 + fr, col0 = u.pn * BM + wc * 32 + 4 * fq;
#pragma unroll
        for (int ai = 0; ai < 2; ++ai)
#pragma unroll
            for (int m = 0; m < 4; ++m) { const size_t off = (size_t)(row0 + ai * HALF + m * 16) * DM + col0;
#pragma unroll
                for (int bj = 0; bj < 2; ++bj)
#pragma unroll
                    for (int n = 0; n < 2; ++n) { const f32x4 bs = *(const f32x4*)(base + off + bj * HALF + n * 16); *(f32x4*)(out + off + bj * HALF + n * 16) = bs * ALPHA + acc[ai][bj][m][n]; } }
    }
};
template <bool BASE_BF16> struct EpiResLn {
    static constexpr bool PERM = false, MID = false, FUSED = true;
    const float* base; const bf16_t* baseb; float* out; bf16_t* xb; const float* gam; const float* bet; float* stats; unsigned* cnt;
    __device__ __forceinline__ void operator()(const Acc&, const Unit&, int, int, int, int) const {}
    __device__ __forceinline__ void fused(Acc& acc, const Unit& u, int wr, int wc, int fr, int fq, LAS unsigned char* lds) const {
        const int row0 = u.pm * BM + wr * 64 + fr, col0 = u.pn * BM + wc * 32 + 4 * fq;
        LAS float* Pst = (LAS float*)lds;
#pragma unroll
        for (int ai = 0; ai < 2; ++ai)
#pragma unroll
            for (int m = 0; m < 4; ++m) { const size_t off = (size_t)(row0 + ai * HALF + m * 16) * DM + col0; float s = 0.f, q = 0.f;
#pragma unroll
                for (int bj = 0; bj < 2; ++bj)
#pragma unroll
                    for (int n = 0; n < 2; ++n) { f32x4 bs; if (BASE_BF16) { const u32x2 wb = *(const u32x2*)(baseb + off + bj * HALF + n * 16); bs = (f32x4){bf_lo(wb.x), bf_hi(wb.x), bf_lo(wb.y), bf_hi(wb.y)}; } else bs = __builtin_nontemporal_load((const f32x4*)(base + off + bj * HALF + n * 16));
                        const f32x4 v = bs * ALPHA + acc[ai][bj][m][n]; acc[ai][bj][m][n] = v;
                        s += (v[0] + v[1]) + (v[2] + v[3]); q += (v[0] * v[0] + v[1] * v[1]) + (v[2] * v[2] + v[3] * v[3]); }
                s += __shfl_xor(s, 16); s += __shfl_xor(s, 32); q += __shfl_xor(q, 16); q += __shfl_xor(q, 32);
                if (fq == 0) { const int rl = ai * HALF + wr * 64 + m * 16 + fr; Pst[(rl * 4 + wc) * 2] = s; Pst[(rl * 4 + wc) * 2 + 1] = q; }
                asm volatile("" ::: "memory"); }
        __syncthreads();
        if (threadIdx.x < 256) { const int rl = threadIdx.x; float s = 0.f, q = 0.f;
#pragma unroll
            for (int w = 0; w < 4; ++w) { s += Pst[(rl * 4 + w) * 2]; q += Pst[(rl * 4 + w) * 2 + 1]; }
            unsigned long long* st = (unsigned long long*)stats + ((size_t)(u.pm * BM + rl) * 8 + u.pn);
            __hip_atomic_store(st, ((unsigned long long)__float_as_uint(q) << 32) | __float_as_uint(s), __ATOMIC_RELAXED, __HIP_MEMORY_SCOPE_AGENT); }
        asm volatile("s_waitcnt vmcnt(0)" ::: "memory");
        __syncthreads();
        if (threadIdx.x == 0) { unsigned* c = cnt + 64 * u.pm; (void)xb_add(c, 1u); unsigned sp = 0u;
            while (xb_ld(c) < 8u) { __builtin_amdgcn_s_sleep(1); if (++sp > XB_SPIN_CAP) break; } }
        __syncthreads();
        LAS float* Sst = (LAS float*)(lds + 8192);
        if (threadIdx.x < 256) { const int rl = threadIdx.x; const unsigned long long* st = (const unsigned long long*)stats + (size_t)(u.pm * BM + rl) * 8; float s = 0.f, q = 0.f;
#pragma unroll
            for (int t = 0; t < 8; ++t) { const unsigned long long v = __hip_atomic_load(st + t, __ATOMIC_RELAXED, __HIP_MEMORY_SCOPE_AGENT); s += __uint_as_float((unsigned)v); q += __uint_as_float((unsigned)(v >> 32)); }
            const float mean = s * (1.0f / DM); const float var = fmaxf(q * (1.0f / DM) - mean * mean, 0.f);
            Sst[rl * 2] = mean; Sst[rl * 2 + 1] = 1.0f / sqrtf(var + LN_EPS); }
        __syncthreads();
#pragma unroll
        for (int ai = 0; ai < 2; ++ai)
#pragma unroll
            for (int m = 0; m < 4; ++m) { const int row = row0 + ai * HALF + m * 16; const size_t off = (size_t)row * DM + col0;
                const int rl = ai * HALF + wr * 64 + m * 16 + fr; const float mean = Sst[rl * 2], rstd = Sst[rl * 2 + 1];
#pragma unroll
                for (int bj = 0; bj < 2; ++bj)
#pragma unroll
                    for (int n = 0; n < 2; ++n) { const int c = col0 + bj * HALF + n * 16; const f32x4 gg = *(const f32x4*)(gam + c), bb = *(const f32x4*)(bet + c);
                        const f32x4 y = (acc[ai][bj][m][n] - mean) * rstd * gg + bb; if (out) __builtin_nontemporal_store(y, (f32x4*)(out + off + bj * HALF + n * 16));
                        if (xb) { u32x2 wv; wv.x = cvt_pk_bf16(y[0], y[1]); wv.y = cvt_pk_bf16(y[2], y[3]); *(u32x2*)(xb + off + bj * HALF + n * 16) = wv; } }
                asm volatile("" ::: "memory"); }
    }
};
}

__device__ __forceinline__ int rope_permd(int d) { return 8 * ((d & 63) >> 2) + 4 * (d >> 6) + (d & 3); }
__device__ __forceinline__ void transpose_item(const float* W, int N, bf16_t* WT, int ldw, int coloff, int row_off, bool rope, LAS float* scr, int kb, int nb, int lane, const float* rscale = nullptr) {
    const int k0 = 64 * kb, n0 = 64 * nb;
    const int lk = lane >> 4, n4 = 4 * (lane & 15);
    f32x4 tv[16];
#pragma unroll
    for (int i = 0; i < 16; ++i) tv[i] = __builtin_nontemporal_load((const f32x4*)(W + (size_t)(k0 + 4 * i + lk) * N + n0 + n4));
#pragma unroll
    for (int i = 0; i < 16; ++i) { const int k = 4 * i + lk; *(LAS f32x4*)(scr + k * 64 + (n4 ^ (4 * (k >> 3)))) = tv[i]; }
    LDS_WAIT(); asm volatile("" ::: "memory");
    const int c = lane & 7;
#pragma unroll
    for (int j = 0; j < 8; ++j) { const int n = (lane >> 3) + 8 * j; const LAS float* s = scr + (8 * c) * 64 + (n ^ (4 * c));
        const float rs = rscale ? rscale[n0 + n] : 1.0f;
        u32x4 o; o.x = cvt_pk_bf16(s[0 * 64] * rs, s[1 * 64] * rs); o.y = cvt_pk_bf16(s[2 * 64] * rs, s[3 * 64] * rs); o.z = cvt_pk_bf16(s[4 * 64] * rs, s[5 * 64] * rs); o.w = cvt_pk_bf16(s[6 * 64] * rs, s[7 * 64] * rs);
        const int ncol = n0 + n; const int drow = (rope && ncol < 2048) ? ((ncol & ~127) + rope_permd(ncol & 127)) : ncol;
        *(u32x4*)(WT + (size_t)(row_off + drow) * ldw + coloff + k0 + 8 * c) = o; }
    LDS_WAIT(); asm volatile("" ::: "memory");
}

struct Ptrs {
    const float *x, *w_in, *w_pool, *pool_scale, *w_ba, *w_bb, *w_out, *ln1g, *ln1b, *w_ff1, *w_ff2, *ln2g, *ln2b; const int* pos;
    float* out; unsigned char* ws;
};

template <bool late> __device__ __forceinline__ void p0_prologue(const Ptrs& P, LAS unsigned char* lds, int G, int bid) {
    const int tid = threadIdx.x, lane = tid & 63, wave = __builtin_amdgcn_readfirstlane(tid >> 6);
    LAS float* scr = (LAS float*)(lds + wave * 16384);
    const int gw = bid * 8 + wave, NGW = G * 8;
    bf16_t* Bt1 = (bf16_t*)(P.ws + WS_BT1); bf16_t* Bt3 = (bf16_t*)(P.ws + WS_BT3); bf16_t* Bt4 = (bf16_t*)(P.ws + WS_BT4); bf16_t* Bt5 = (bf16_t*)(P.ws + WS_BT5); bf16_t* Bt6 = (bf16_t*)(P.ws + WS_BT6); bf16_t* WpT = (bf16_t*)(P.ws + WS_WPT);
    constexpr int I_IN = (DM / 64) * (IW / 64), I_PL = 4 * (256 / 64) * (256 / 64), I_BA = (AW / 64) * (DM / 64), I_OUT = (DM / 64) * (DM / 64), I_F1 = (DM / 64) * (FF / 64), I_F2 = (FF / 64) * (DM / 64);
    constexpr int NITEMS = late ? (2 * I_BA + I_OUT + I_F1 + I_F2) : (I_IN + I_PL);
    for (int it = gw; it < NITEMS; it += NGW) {
        int r = it;
        if (late) {
            if (r < I_BA) { transpose_item(P.w_ba, DM, Bt3, 2048, 0, 0, false, scr, r / (DM / 64), r % (DM / 64), lane); continue; } r -= I_BA;
            if (r < I_BA) { transpose_item(P.w_bb, DM, Bt3, 2048, 1024, 0, false, scr, r / (DM / 64), r % (DM / 64), lane); continue; } r -= I_BA;
            if (r < I_OUT) { transpose_item(P.w_out, DM, Bt4, DM, 0, 0, false, scr, r / (DM / 64), r % (DM / 64), lane); continue; } r -= I_OUT;
            if (r < I_F1) { transpose_item(P.w_ff1, FF, Bt5, DM, 0, 0, false, scr, r / (FF / 64), r % (FF / 64), lane); continue; } r -= I_F1;
            transpose_item(P.w_ff2, DM, Bt6, FFP, 0, 0, false, scr, r / (DM / 64), r % (DM / 64), lane); continue; }
        if (r < I_IN) { transpose_item(P.w_in, IW, Bt1, DM, 0, 0, true, scr, r / (IW / 64), r % (IW / 64), lane); continue; } r -= I_IN;
        { const int g = r / 16, q = r % 16; transpose_item(P.w_pool + (size_t)g * 65536, 256, WpT, 256, 0, g * 256, false, scr, q / 4, q % 4, lane, P.pool_scale + g * 256); }
    }
    if (late) return;
    const int gt = bid * 512 + tid, NGT = G * 512;
    bf16_t* xb = (bf16_t*)(P.ws + WS_XB);
    for (int i = gt; i < S * DM / 8; i += NGT) { const f32x4 a = __builtin_nontemporal_load((const f32x4*)(P.x + (size_t)i * 8)), b = __builtin_nontemporal_load((const f32x4*)(P.x + (size_t)i * 8 + 4));
        u32x4 w; w.x = cvt_pk_bf16(a[0], a[1]); w.y = cvt_pk_bf16(a[2], a[3]); w.z = cvt_pk_bf16(b[0], b[1]); w.w = cvt_pk_bf16(b[2], b[3]); *(u32x4*)(xb + (size_t)i * 8) = w; }
    float* cosT = (float*)(P.ws + WS_COS); float* sinT = (float*)(P.ws + WS_SIN);
    const double invf_rev = exp(-(double)(gt & 63) * (9.210340371976184 / 64.0)) * 0.15915494309189535;
    for (int i = gt; i < S * 64; i += NGT) { const int t = i >> 6, f = i & 63;
        const double invf = (NGT & 63) ? exp(-(double)f * (9.210340371976184 / 64.0)) * 0.15915494309189535 : invf_rev; const double rev = (double)P.pos[t] * invf; const float fr = (float)(rev - floor(rev));
        cosT[i] = __builtin_amdgcn_cosf(fr); sinT[i] = __builtin_amdgcn_sinf(fr); }
}

__device__ __forceinline__ unsigned off_k(unsigned row, unsigned ch) { return 256u * row + 16u * (ch ^ (row & 15u)); }
__device__ __forceinline__ unsigned off_v(unsigned row, unsigned ch) { return 256u * row + 16u * (ch ^ ((row & 7u) << 1)); }
#define VTR(dst, addr, imm) asm volatile("ds_read_b64_tr_b16 %0, %1 offset:%c2" : "=&v"(dst) : "v"(addr), "i"(imm) : "memory")

__device__ __forceinline__ void attn_phase(const Ptrs& P, LAS unsigned char* lds, int G, int bid) {
    const int tid = threadIdx.x, lane = tid & 63, w = __builtin_amdgcn_readfirstlane(tid >> 6), ql = lane & 15, g = lane >> 4;
    const bf16_t* H1 = (const bf16_t*)(P.ws + WS_H1);
    bf16_t* OP = (bf16_t*)(P.ws + WS_OP); float* LSE = (float*)(P.ws + WS_LSE);
    LAS unsigned char* Ks = lds; LAS unsigned char* Vs = lds + 65536;
    const unsigned vbase = (unsigned)(size_t)Vs;
    const int srow = tid >> 4, sch = tid & 15;
    const unsigned soffK = off_k((unsigned)srow, (unsigned)sch), soffV = off_v((unsigned)srow, (unsigned)sch);
    unsigned vb[8];
    { const unsigned q4 = (unsigned)(lane & 15) >> 2, p4 = (unsigned)lane & 3;
#pragma unroll
      for (int c = 0; c < 8; ++c) vb[c] = vbase + off_v(16u * (unsigned)w + 4u * (unsigned)g + q4, 2u * c + (p4 >> 1)) + 8u * (p4 & 1u); }
#define ATT_DECODE(u_, p_, h_, r_, n_, dil_) const int p_ = (u_) >> 9, h_ = ((u_) & 511) >> 6; const int dil_ = 1 << (2 * p_); const int r_ = ((u_) & 63) >> (6 - 2 * p_), n_ = ((u_) & 63) & ((64 >> (2 * p_)) - 1)
    u32x4 kreg[8], vreg[8];
#define ATT_LOAD_TILE(dst, coloff, n_, dil_, r_, h_) do { _Pragma("unroll") for (int i = 0; i < 8; ++i) { dst[i] = (u32x4){0u, 0u, 0u, 0u}; \
        if (!((n_) == 0 && i < 4)) dst[i] = *(const u32x4*)(H1 + (size_t)((128 * ((n_) - 1) + srow + 32 * i) * (dil_) + (r_)) * 4096 + (coloff) + (h_) * 128 + sch * 8); } } while (0)
    { ATT_DECODE(bid, p, h, r, n, dil);
      if (bid < 3 * 512) { ATT_LOAD_TILE(kreg, 1024, n, dil, r, h); ATT_LOAD_TILE(vreg, 2048, n, dil, r, h); } }
    for (int u = bid; u < 3 * 512; u += G) {
        ATT_DECODE(u, p, h, r, n, dil);
#pragma unroll
        for (int i = 0; i < 8; ++i) *(LAS u32x4*)(Ks + soffK + 8192 * i) = kreg[i];
        const bool has_next = (u + G < 3 * 512);
        ATT_DECODE(u + G, p2, h2, r2, n2, dil2);
        if (has_next) ATT_LOAD_TILE(kreg, 1024, n2, dil2, r2, h2);
        const int qpos = (128 * n + 16 * w + ql) * dil + r;
        bf16x8 qf[4];
#pragma unroll
        for (int ks = 0; ks < 4; ++ks) qf[ks] = *(const bf16x8*)(H1 + (size_t)qpos * 4096 + h * 128 + 32 * ks + 8 * g);
        __syncthreads();
        f32x4 s[9];
#pragma unroll
        for (int t = 0; t < 9; ++t) { s[t] = (f32x4){0.f, 0.f, 0.f, 0.f};
#pragma unroll
            for (int ks = 0; ks < 4; ++ks) { const bf16x8 kf = *(const LAS bf16x8*)(Ks + off_k(16 * (w + t) + ql, 4 * ks + g)); s[t] = __builtin_amdgcn_mfma_f32_16x16x32_bf16(kf, qf[ks], s[t], 0, 0, 0); } }
        const float NEG = -INFINITY;
#pragma unroll
        for (int j = 0; j < 4; ++j) { const int kk = 4 * g + j; if (kk < ql) s[0][j] = NEG; if (kk > ql) s[8][j] = NEG; }
        if (n == 0) {
#pragma unroll
            for (int t = 0; t < 8; ++t) if (w + t < 8) s[t] = (f32x4){NEG, NEG, NEG, NEG}; }
        float mx = NEG;
#pragma unroll
        for (int t = 0; t < 9; ++t) mx = fmaxf(mx, fmaxf(fmaxf(s[t][0], s[t][1]), fmaxf(s[t][2], s[t][3])));
        mx = fmaxf(mx, __shfl_xor(mx, 16)); mx = fmaxf(mx, __shfl_xor(mx, 32));
        float l = 0.f;
#pragma unroll
        for (int t = 0; t < 9; ++t) {
#pragma unroll
            for (int j = 0; j < 4; ++j) { const float e = __builtin_amdgcn_exp2f(s[t][j] - mx); s[t][j] = e; l += e; } }
        l += __shfl_xor(l, 16); l += __shfl_xor(l, 32);
#pragma unroll
        for (int i = 0; i < 8; ++i) *(LAS u32x4*)(Vs + soffV + 8192 * i) = vreg[i];
        __syncthreads();
        f32x4 o[8];
#pragma unroll
        for (int c = 0; c < 8; ++c) o[c] = (f32x4){0.f, 0.f, 0.f, 0.f};
#pragma unroll
        for (int kp = 0; kp < 5; ++kp) { const int t0 = 2 * kp, t1 = (2 * kp + 1 < 9) ? 2 * kp + 1 : 2 * kp;
            bf16x8 pf; { const unsigned a = cvt_pk_bf16(s[t0][0], s[t0][1]), b = cvt_pk_bf16(s[t0][2], s[t0][3]);
                unsigned c2 = 0u, d2 = 0u; if (2 * kp + 1 < 9) { c2 = cvt_pk_bf16(s[t1][0], s[t1][1]); d2 = cvt_pk_bf16(s[t1][2], s[t1][3]); }
                const u32x4 pw = (u32x4){a, b, c2, d2}; pf = __builtin_bit_cast(bf16x8, pw); }
            s16x4 lo[8], hi[8];
#pragma unroll
            for (int c = 0; c < 8; ++c) { VTR(lo[c], vb[c], 4096 * t0); VTR(hi[c], vb[c], 4096 * t1); }
            LDS_WAIT(); __builtin_amdgcn_sched_barrier(0);
#pragma unroll
            for (int c = 0; c < 8; ++c) { const bf16x8 vf = (bf16x8){lo[c][0], lo[c][1], lo[c][2], lo[c][3], hi[c][0], hi[c][1], hi[c][2], hi[c][3]};
                o[c] = __builtin_amdgcn_mfma_f32_16x16x32_bf16(vf, pf, o[c], 0, 0, 0); }
        }
        if (has_next) ATT_LOAD_TILE(vreg, 2048, n2, dil2, r2, h2);
        const float inv = 1.0f / l;
        LAS unsigned char* ost = lds + OST_OFF + w * 2304;
        const int orow = lane >> 2, oseg = lane & 3;
        bf16_t* op = OP + (size_t)p * S * AW + (size_t)((128 * n + 16 * w + orow) * dil + r) * AW + h * 128 + 16 * oseg;
#pragma unroll
        for (int hf = 0; hf < 2; ++hf) {
#pragma unroll
            for (int cc = 0; cc < 4; ++cc) { const int c = 4 * hf + cc; u32x2 wv; wv.x = cvt_pk_bf16(o[c][0] * inv, o[c][1] * inv); wv.y = cvt_pk_bf16(o[c][2] * inv, o[c][3] * inv);
                *(LAS u32x2*)(ost + ql * 144 + cc * 32 + g * 8) = wv; }
            asm volatile("" ::: "memory");
            const u32x4 r0 = *(const LAS u32x4*)(ost + orow * 144 + oseg * 32), r1 = *(const LAS u32x4*)(ost + orow * 144 + oseg * 32 + 16);
            asm volatile("" ::: "memory");
            *(u32x4*)(op + 64 * hf) = r0; *(u32x4*)(op + 64 * hf + 8) = r1;
        }
        if (g == 0) LSE[((size_t)p * S + qpos) * NH + h] = mx + __builtin_amdgcn_logf(l);
    }
    __syncthreads();
    bf16_t* Pp = (bf16_t*)(P.ws + WS_P);
    const int gt = bid * 512 + tid, NGT = G * 512;
    for (int i = gt; i < (S / 32) * 128; i += NGT) { const int ch = i & 127, t0 = (i >> 7) * 32; const int win = 2 << (ch >> 5);
        const bf16_t* src = H1 + (size_t)t0 * 4096 + 3072 + ch * 8;
        float ws8[8];
#pragma unroll
        for (int e = 0; e < 8; ++e) ws8[e] = 0.f;
        for (int j = 1; j <= win; ++j) if (t0 - j >= 0) { const u32x4 y = *(const u32x4*)(src - (size_t)j * 4096);
            ws8[0] += bf_lo(y.x); ws8[1] += bf_hi(y.x); ws8[2] += bf_lo(y.y); ws8[3] += bf_hi(y.y); ws8[4] += bf_lo(y.z); ws8[5] += bf_hi(y.z); ws8[6] += bf_lo(y.w); ws8[7] += bf_hi(y.w); }
#pragma unroll 8
        for (int s = 0; s < 32; ++s) { const int t = t0 + s; const u32x4 x0 = *(const u32x4*)(src + (size_t)s * 4096);
            u32x4 y = (u32x4){0u, 0u, 0u, 0u}; if (t - win >= 0) y = *(const u32x4*)(src + (size_t)(s - win) * 4096);
            const float xs[8] = {bf_lo(x0.x), bf_hi(x0.x), bf_lo(x0.y), bf_hi(x0.y), bf_lo(x0.z), bf_hi(x0.z), bf_lo(x0.w), bf_hi(x0.w)};
            const float ys[8] = {bf_lo(y.x), bf_hi(y.x), bf_lo(y.y), bf_hi(y.y), bf_lo(y.z), bf_hi(y.z), bf_lo(y.w), bf_hi(y.w)};
            const int cnt = (t + 1 < win) ? t + 1 : win; const float ic = 1.0f / (float)cnt;
            float pv[8];
#pragma unroll
            for (int e = 0; e < 8; ++e) { ws8[e] += xs[e] - ys[e]; pv[e] = ws8[e] * ic - xs[e]; }
            u32x4 wv; wv.x = cvt_pk_bf16(pv[0], pv[1]); wv.y = cvt_pk_bf16(pv[2], pv[3]); wv.z = cvt_pk_bf16(pv[4], pv[5]); wv.w = cvt_pk_bf16(pv[6], pv[7]);
            *(u32x4*)(Pp + (size_t)t * AW + ch * 8) = wv; }
    }
}

__device__ __forceinline__ void combine_phase(const Ptrs& P, int G, int bid) {
    const bf16_t* OP = (const bf16_t*)(P.ws + WS_OP); const float* LSE = (const float*)(P.ws + WS_LSE); bf16_t* A3 = (bf16_t*)(P.ws + WS_A3);
    int start, cnt;
    if (G == 256) { start = (bid < 128) ? bid * 2048 : 128 * 2048 + (bid - 128) * 6144; cnt = (bid < 128) ? 2048 : 6144; }
    else { const int per = (S * 128 + G - 1) / G; start = bid * per; cnt = (start + per <= S * 128) ? per : (S * 128 > start ? S * 128 - start : 0); }
    for (int b0 = threadIdx.x; b0 < cnt; b0 += 4 * 512) {
        u32x4 a[4], b[4], c[4]; float l0[4], l1[4], l2[4];
#pragma unroll
        for (int k = 0; k < 4; ++k) { const int ii = b0 + 512 * k; const int i = start + (ii < cnt ? ii : b0); const int t = i >> 7, ch = i & 127, h = ch >> 4;
            l0[k] = LSE[((size_t)0 * S + t) * NH + h]; l1[k] = LSE[((size_t)1 * S + t) * NH + h]; l2[k] = LSE[((size_t)2 * S + t) * NH + h];
            const size_t off = (size_t)t * AW + ch * 8;
            a[k] = __builtin_nontemporal_load((const u32x4*)(OP + off)); b[k] = __builtin_nontemporal_load((const u32x4*)(OP + (size_t)S * AW + off)); c[k] = __builtin_nontemporal_load((const u32x4*)(OP + 2 * (size_t)S * AW + off)); }
#pragma unroll
        for (int k = 0; k < 4; ++k) { const int ii = b0 + 512 * k; if (ii < cnt) { const int i = start + ii; const int t = i >> 7, ch = i & 127;
            const float m = fmaxf(l0[k], fmaxf(l1[k], l2[k])); float w0 = __builtin_amdgcn_exp2f(l0[k] - m), w1 = __builtin_amdgcn_exp2f(l1[k] - m), w2 = __builtin_amdgcn_exp2f(l2[k] - m);
            const float is = 1.0f / (w0 + w1 + w2); w0 *= is; w1 *= is; w2 *= is;
            u32x4 wv;
            wv.x = cvt_pk_bf16(w0 * bf_lo(a[k].x) + w1 * bf_lo(b[k].x) + w2 * bf_lo(c[k].x), w0 * bf_hi(a[k].x) + w1 * bf_hi(b[k].x) + w2 * bf_hi(c[k].x));
            wv.y = cvt_pk_bf16(w0 * bf_lo(a[k].y) + w1 * bf_lo(b[k].y) + w2 * bf_lo(c[k].y), w0 * bf_hi(a[k].y) + w1 * bf_hi(b[k].y) + w2 * bf_hi(c[k].y));
            wv.z = cvt_pk_bf16(w0 * bf_lo(a[k].z) + w1 * bf_lo(b[k].z) + w2 * bf_lo(c[k].z), w0 * bf_hi(a[k].z) + w1 * bf_hi(b[k].z) + w2 * bf_hi(c[k].z));
            wv.w = cvt_pk_bf16(w0 * bf_lo(a[k].w) + w1 * bf_lo(b[k].w) + w2 * bf_lo(c[k].w), w0 * bf_hi(a[k].w) + w1 * bf_hi(b[k].w) + w2 * bf_hi(c[k].w));
            *(u32x4*)(A3 + (size_t)t * DM + ch * 8) = wv; } }
    }
}

__device__ __forceinline__ float wave_sum(float v) {
#pragma unroll
    for (int o = 1; o < 64; o <<= 1) v += __shfl_xor(v, o);
    return v;
}
__device__ __forceinline__ void ln_phase(float* X, const float* gam, const float* bet, bf16_t* xb, int G, int bid) {
    const int lane = threadIdx.x & 63, wave = threadIdx.x >> 6; const int gw = bid * 8 + wave, NGW = G * 8;
    for (int row = gw; row < S; row += NGW) { f32x4* xr = (f32x4*)(X + (size_t)row * DM) + lane;
        f32x4 v[8]; float s = 0.f;
#pragma unroll
        for (int j = 0; j < 8; ++j) { v[j] = xr[64 * j]; s += (v[j][0] + v[j][1]) + (v[j][2] + v[j][3]); }
        const float mean = wave_sum(s) * (1.0f / DM); float s2 = 0.f;
#pragma unroll
        for (int j = 0; j < 8; ++j) { v[j] = v[j] - mean; s2 += (v[j][0] * v[j][0] + v[j][1] * v[j][1]) + (v[j][2] * v[j][2] + v[j][3] * v[j][3]); }
        const float rstd = 1.0f / sqrtf(wave_sum(s2) * (1.0f / DM) + LN_EPS);
#pragma unroll
        for (int j = 0; j < 8; ++j) { const f32x4 gg = *((const f32x4*)gam + lane + 64 * j), bb = *((const f32x4*)bet + lane + 64 * j); const f32x4 y = v[j] * rstd * gg + bb; xr[64 * j] = y;
            if (xb) { u32x2 wv; wv.x = cvt_pk_bf16(y[0], y[1]); wv.y = cvt_pk_bf16(y[2], y[3]); *((u32x2*)(xb + (size_t)row * DM) + lane + 64 * j) = wv; } }
    }
}

struct Args { const void* in[14]; float* out; unsigned char* ws; int ph_lo, ph_hi; };
__global__ void __launch_bounds__(512, 2) mega_fwd(Args a) {
    extern __shared__ __attribute__((aligned(16))) unsigned char lds_raw[];
    LAS unsigned char* lds = (LAS unsigned char*)lds_raw;
    Ptrs P;
    P.x = (const float*)a.in[0]; P.pos = (const int*)a.in[1]; P.w_in = (const float*)a.in[2]; P.w_pool = (const float*)a.in[3]; P.pool_scale = (const float*)a.in[4];
    P.w_ba = (const float*)a.in[5]; P.w_bb = (const float*)a.in[6]; P.w_out = (const float*)a.in[7]; P.ln1g = (const float*)a.in[8]; P.ln1b = (const float*)a.in[9];
    P.w_ff1 = (const float*)a.in[10]; P.w_ff2 = (const float*)a.in[11]; P.ln2g = (const float*)a.in[12]; P.ln2b = (const float*)a.in[13]; P.out = a.out; P.ws = a.ws;
    const int G = gridDim.x, bid = blockIdx.x;
    const int lo = a.ph_lo, hi = a.ph_hi;
    unsigned char* ws = a.ws;
#ifndef PHASE_MASK
#define PHASE_MASK 0x3ff
#endif
#define IN(k) (((PHASE_MASK >> (k)) & 1) && lo <= (k) && (k) < hi)
    volatile LAS unsigned* bst = (volatile LAS unsigned*)(lds + 131072 + 64);
    if (threadIdx.x < 2) bst[threadIdx.x] = 0u;
    __syncthreads();
    XcdBarrier xbar; xbar.bar = (unsigned*)ws; xbar.x = 0; xbar.st = bst;
    xbar = xcd_barrier_post((unsigned*)ws, bst);
#define SEAM(k) do { if (IN(k) && IN((k) + 1)) { if (hi > NPH) cg::this_grid().sync();   else xcd_barrier(xbar); } } while (0)
#ifndef REP_MASK
#define REP_MASK 0
#endif
    if (IN(0)) { p0_prologue<false>(P, lds, G, bid); __syncthreads(); }
    SEAM(0);
    if (REP_MASK & 1024) { xcd_barrier(xbar); xcd_barrier(xbar); xcd_barrier(xbar); xcd_barrier(xbar); }
    if (IN(1)) {
        pg8::Gemm g{(const bf16_t*)(ws + WS_XB), (const bf16_t*)(ws + WS_BT1), DM, DM, DM, 0}; pg8::StaticOrder so; so.init(S, IW, G, bid, 1);
        pg8::Epi1 E{(bf16_t*)(ws + WS_H1), (bf16_t*)(ws + WS_G), (const float*)(ws + WS_COS), (const float*)(ws + WS_SIN)};
        pg8::gemm_phase(lds, g, so, E);
        if (REP_MASK & 2) { __syncthreads(); pg8::gemm_phase(lds, g, so, E); }
    }
    SEAM(1);
    if (IN(2)) { const int vcu = (G % 8 == 0) ? (bid % 8) * (G / 8) + bid / 8 : bid;
        attn_phase(P, lds, G, vcu); if (REP_MASK & 4) { __syncthreads(); attn_phase(P, lds, G, vcu); } }
    SEAM(2);
    if (IN(3)) {
        pg8::Gemm g{(const bf16_t*)(ws + WS_P), (const bf16_t*)(ws + WS_WPT), AW, 256, 256, 512}; pg8::StaticOrder so; so.init(S, 1024, G, bid);
        pg8::EpiBf16<0> E{(bf16_t*)(ws + WS_A3), DM, 1024, nullptr};
        pg8::gemm_phase(lds, g, so, E);
        combine_phase(P, G, bid);
        p0_prologue<true>(P, lds, G, bid);
    }
    SEAM(3);
    if (IN(4)) {
        pg8::Gemm g{(const bf16_t*)(ws + WS_A3), (const bf16_t*)(ws + WS_BT3), DM, 2048, 1024  , 0}; pg8::StaticOrder so; so.init(S, DM, G, bid);
        pg8::Epi3 E{(bf16_t*)(ws + WS_MRG), (const bf16_t*)(ws + WS_G)};
        pg8::gemm_phase(lds, g, so, E);
        if (REP_MASK & 16) { __syncthreads(); pg8::gemm_phase(lds, g, so, E); }
    }
    SEAM(4);
    if (IN(5)) {
        pg8::Gemm g{(const bf16_t*)(ws + WS_MRG), (const bf16_t*)(ws + WS_BT4), DM, DM, DM, 0}; pg8::StaticOrder so; so.init(S, DM, G, bid);
        pg8::EpiResLn<false> E{P.x, nullptr, nullptr, (bf16_t*)(ws + WS_X1B), P.ln1g, P.ln1b, (float*)(ws + WS_ST1), (unsigned*)(ws + 16384)};
        pg8::gemm_phase(lds, g, so, E);
    }
    SEAM(5);
    if (IN(7)) {
        pg8::Gemm g{(const bf16_t*)(ws + WS_X1B), (const bf16_t*)(ws + WS_BT5), DM, DM, DM, 0}; pg8::StaticOrder so; so.init(S, FF, G, bid);
        pg8::EpiBf16<1> E{(bf16_t*)(ws + WS_ACT), FFP, 0, nullptr};
        pg8::gemm_phase(lds, g, so, E);
        if (REP_MASK & 128) { __syncthreads(); pg8::gemm_phase(lds, g, so, E); }
    }
    SEAM(7);
    if (IN(8)) {
        pg8::Gemm g{(const bf16_t*)(ws + WS_ACT), (const bf16_t*)(ws + WS_BT6), FFP, FFP, FF, 0}; pg8::StaticOrder so; so.init(S, DM, G, bid);

        pg8::EpiResLn<true> E{nullptr, (const bf16_t*)(ws + WS_X1B), P.out, nullptr, P.ln2g, P.ln2b, (float*)(ws + WS_ST2), (unsigned*)(ws + 24576)};
        pg8::gemm_phase(lds, g, so, E);
    }
#undef IN
#undef SEAM
}

#ifdef DBG_STOP
__global__ void dbg_dump(const bf16_t* src, float* out, int n) { for (int i = blockIdx.x * blockDim.x + threadIdx.x; i < n; i += gridDim.x * blockDim.x) out[i] = __builtin_bit_cast(float, (unsigned)src[i] << 16); }
#endif
extern "C" void kernel_launch(void* const* d_in, const int* in_sizes, int n_in, void* d_out, int out_size, void* d_ws, size_t ws_size, hipStream_t stream) {
    static int grid = 0;
    if (grid == 0) {
        if (n_in != 14 || out_size != S * DM || ws_size < WS_END) { fprintf(stderr, "kernel_launch: unexpected problem (n_in %d, out %d, ws %zu < %zu)\n", n_in, out_size, ws_size, (size_t)WS_END); grid = -1; return; }
        if (hipFuncSetAttribute((const void*)mega_fwd, hipFuncAttributeMaxDynamicSharedMemorySize, LDS_BYTES) != hipSuccess) { fprintf(stderr, "kernel_launch: hipFuncSetAttribute failed\n"); grid = -1; return; }
        int dev = 0, cus = 0, per_cu = 0;
        hipGetDevice(&dev); hipDeviceGetAttribute(&cus, hipDeviceAttributeMultiprocessorCount, dev);
        hipOccupancyMaxActiveBlocksPerMultiprocessor(&per_cu, (const void*)mega_fwd, 512, LDS_BYTES);
        if (per_cu < 1) { fprintf(stderr, "kernel_launch: occupancy query says %d blocks per CU\n", per_cu); per_cu = 1; }
        (void)hipGetLastError();
        grid = cus;
    }
    if (grid < 0) return;
    Args a{};
    for (int i = 0; i < 14; ++i) a.in[i] = d_in[i];
    a.out = (float*)d_out; a.ws = (unsigned char*)d_ws;
#if N_LAUNCH_MODE == 0
    if (hipMemsetAsync(d_ws, 0, WS_ZERO_BYTES, stream) != hipSuccess) { fprintf(stderr, "kernel_launch: memset of the barrier words failed\n"); return; }
    a.ph_lo = 0; a.ph_hi = NPH;
    void* args[] = {&a};
    hipError_t e = hipLaunchCooperativeKernel((const void*)mega_fwd, dim3(grid), dim3(512), args, LDS_BYTES, stream);
    if (e != hipSuccess) fprintf(stderr, "cooperative launch failed: %s (grid %d)\n", hipGetErrorString(e), grid);
#else
#ifdef DBG_STOP
    for (int ph = 0; ph <= DBG_STOP; ++ph) { a.ph_lo = ph; a.ph_hi = ph + 1; hipLaunchKernelGGL(mega_fwd, dim3(grid), dim3(512), LDS_BYTES, stream, a); }
    hipLaunchKernelGGL(dbg_dump, dim3(2048), dim3(256), 0, stream, (const bf16_t*)((unsigned char*)d_ws + (size_t)DBG_OFF * MiB), (float*)d_out, S * DM);
#else
    for (int ph = 0; ph < NPH; ++ph) { a.ph_lo = ph; a.ph_hi = ph + 1; hipLaunchKernelGGL(mega_fwd, dim3(grid), dim3(512), LDS_BYTES, stream, a); }
#endif
#endif
}
```

```cpp
#include <hip/hip_runtime.h>
#include <hip/hip_cooperative_groups.h>
#include <cstdio>
#include <cstdint>
namespace cg = cooperative_groups;

#ifndef N_LAUNCH_MODE
#define N_LAUNCH_MODE 0
#endif

#define LAS __attribute__((address_space(3)))
typedef unsigned short bf16_t;
typedef short bf16x8 __attribute__((ext_vector_type(8)));
typedef short s16x4 __attribute__((ext_vector_type(4)));
typedef float f32x4 __attribute__((ext_vector_type(4)));
typedef unsigned u32x4 __attribute__((ext_vector_type(4)));
typedef unsigned u32x2 __attribute__((ext_vector_type(2)));

constexpr int S = 8192, DM = 2048, IW = 8192, AW = 1024, FF = 8192, NH = 8;
constexpr float LN_EPS = 1e-5f;
constexpr float ALPHA = 1.189207115002721f;
constexpr float QSCALE = 0.08838834764831845f * 1.4426950408889634f;
constexpr int NPH = 10;

constexpr size_t MiB = 1u << 20;
constexpr size_t WS_ST1 = 65536, WS_ST2 = 82 * MiB + 524288  , WS_ZERO_BYTES = 32768;
static_assert(WS_ST1 + 524288 <= (1u << 20), "control MiB");
constexpr int FFP = FF + 64;
constexpr size_t WS_BT5 = 1 * MiB, WS_BT6 = 33 * MiB, WS_BT3 = 66 * MiB, WS_BT4 = 74 * MiB, WS_WPT = 82 * MiB, WS_COS = 83 * MiB, WS_SIN = 85 * MiB, WS_LSE = 87 * MiB;
constexpr size_t WS_X = 88 * MiB;
constexpr size_t WS_BT1 = WS_X, WS_XB = WS_X + 32 * MiB, WS_OP = WS_X, WS_P = WS_X + 48 * MiB, WS_MRG = WS_X, WS_X1B = WS_X;
constexpr size_t WS_H1 = 152 * MiB, WS_A3 = WS_H1, WS_G = 216 * MiB, WS_ACT = 152 * MiB, WS_END = 281 * MiB;
static_assert(WS_BT6 + (size_t)DM * FFP * 2 <= WS_BT3 && WS_ACT + (size_t)S * FFP * 2 <= WS_END, "workspace map");

constexpr int OST_OFF = 131072 + 1024;
constexpr int LDS_BYTES = OST_OFF + 8 * 2304;

typedef float f32x2_t __attribute__((ext_vector_type(2))); typedef __bf16 bf16x2_t __attribute__((ext_vector_type(2)));
__device__ __forceinline__ unsigned cvt_pk_bf16(float lo, float hi) { f32x2_t v = {lo, hi}; bf16x2_t b = __builtin_convertvector(v, bf16x2_t); return __builtin_bit_cast(unsigned, b); }
__device__ __forceinline__ float bf_lo(unsigned w) { return __builtin_bit_cast(float, w << 16); }
__device__ __forceinline__ float bf_hi(unsigned w) { return __builtin_bit_cast(float, w & 0xffff0000u); }
#define LDS_WAIT() asm volatile("s_waitcnt lgkmcnt(0)" ::: "memory")

#define XB_TMO      128
#define XB_XCNT(j)  (256  + 64 * (j))
#define XB_XSUB(j)  (1280 + 64 * (j))
#define XB_XGEN(j)  (2304 + 64 * (j))
#define XB_TOP      3328
#define XB_TOPGEN   3392
#define XCD_BAR_WORDS 3456
#define XB_SPIN_CAP (1u << 22)
__device__ __forceinline__ unsigned xb_ld(unsigned* p)              { return __hip_atomic_load(p, __ATOMIC_RELAXED, __HIP_MEMORY_SCOPE_AGENT); }
__device__ __forceinline__ unsigned xb_add(unsigned* p, unsigned v) { return __hip_atomic_fetch_add(p, v, __ATOMIC_RELAXED, __HIP_MEMORY_SCOPE_AGENT); }
__device__ __forceinline__ unsigned xb_xcc_id() { return (unsigned)__builtin_amdgcn_s_getreg((3 << 11) | 20) & 0xFu; }
#define XB_SPIN(cond, bar) do { unsigned _sp = 0; while (cond) { __builtin_amdgcn_s_sleep(1); \
    if ((++_sp & 255u) == 0u) { if (xb_ld(&(bar)[XB_TMO])) break; if (_sp > XB_SPIN_CAP) { atomicAdd(&(bar)[XB_TMO], 1u); break; } } } } while (0)
struct XcdBarrier { unsigned* bar; unsigned x; volatile LAS unsigned* st; };
__device__ __forceinline__ XcdBarrier xcd_barrier_post(unsigned* bar, volatile LAS unsigned* st) {
    XcdBarrier b; b.bar = bar; b.x = xb_xcc_id(); b.st = st;
    if (threadIdx.x == 0) (void)xb_add(&bar[XB_XCNT(b.x)], 1u);
    return b;
}
__device__ __forceinline__ void xcd_barrier_complete(unsigned* bar, unsigned x, unsigned& nloc, unsigned& nx) {
    const unsigned G = gridDim.x * gridDim.y * gridDim.z;
    unsigned sum, cnt, mine, sp = 0u;
    for (;;) {
        sum = 0u; cnt = 0u; mine = 0u;
#pragma unroll
        for (unsigned j = 0; j < 16; ++j) { const unsigned c = xb_ld(&bar[XB_XCNT(j)]); sum += c; cnt += (c > 0u) ? 1u : 0u; mine = (j == x) ? c : mine; }
        if (sum == G) break;
        __builtin_amdgcn_s_sleep(1);
        if ((++sp & 255u) == 0u) { if (xb_ld(&bar[XB_TMO])) break; if (sp > XB_SPIN_CAP) { atomicAdd(&bar[XB_TMO], 1u); break; } }
    }
    nloc = mine > 0u ? mine : 1u; nx = cnt > 0u ? cnt : 1u;
}
__device__ __forceinline__ void xcd_barrier(const XcdBarrier& b) {
    asm volatile("s_waitcnt vmcnt(0)" ::: "memory");
    __syncthreads();
    if (threadIdx.x == 0) {
        unsigned* bar = b.bar;
        __builtin_amdgcn_s_waitcnt(0);
        unsigned nloc = b.st[0], nx = b.st[1];
        if (nloc == 0u) { xcd_barrier_complete(bar, b.x, nloc, nx); b.st[0] = nloc; b.st[1] = nx; }
        const unsigned old = xb_add(&bar[XB_XSUB(b.x)], 1u);
        const unsigned gen = old / nloc;
        if (old + 1u == (gen + 1u) * nloc) {
            __builtin_amdgcn_fence(__ATOMIC_RELEASE, "agent");
            asm volatile("s_waitcnt vmcnt(0)" ::: "memory");
            const unsigned og = xb_add(&bar[XB_TOP], 1u);
            const unsigned tg = og / nx;
            if (og + 1u == (tg + 1u) * nx) xb_add(&bar[XB_TOPGEN], 1u);
            else XB_SPIN(xb_ld(&bar[XB_TOPGEN]) == tg, bar);
            __builtin_amdgcn_fence(__ATOMIC_ACQUIRE, "agent");
            xb_add(&bar[XB_XGEN(b.x)], 1u);
            asm volatile("s_waitcnt vmcnt(0)" ::: "memory");
        } else {
            XB_SPIN(xb_ld(&bar[XB_XGEN(b.x)]) == gen, bar);
            __builtin_amdgcn_fence(__ATOMIC_ACQUIRE, "agent");
            asm volatile("s_waitcnt vmcnt(0)" ::: "memory");
        }
    }
    __syncthreads();
}

namespace pg8 {
constexpr int BM = 256, BK = 64, HALF = 128, HTB = HALF * BK * 2, NXCD = 8, WGM = 4;
__host__ __device__ __forceinline__ int lds_byte(int r, int c) { const int st = (r >> 4) * 2 + (c >> 5), rr = r & 15, cc = c & 31, ob = rr * 64 + cc * 2; return st * 1024 + (ob ^ (((ob >> 9) & 1) << 5)); }
__host__ __device__ __forceinline__ void stage_rc(int b, int& R, int& C) { const int st = b / 1024, sb = b % 1024, swz = sb ^ (((sb >> 9) & 1) << 5); R = (st >> 1) * 16 + swz / 64; C = (st & 1) * 32 + (swz % 64) / 2; }
__host__ __device__ __forceinline__ int perm32(int rho) { const int n = rho >> 4, i = rho & 15; return 8 * (i >> 2) + 4 * n + (i & 3); }

struct Unit { int pm, pn; };
struct Gemm { const bf16_t* A; const bf16_t* Bt; int lda, ldb, K, apn; };

struct StaticOrder {
    int nM, nN, nwg, G, c, mix;
    __device__ void init(int M, int N, int G_, int c_, int mix_ = 0) { nM = M / BM; nN = N / BM; nwg = nM * nN; G = G_; c = c_; mix = mix_; }
    __device__ bool next(int i, Unit& u) const {
        const long L = (long)i * G + c; if (L >= nwg) return false;
        int wgid = (int)L; { const int q = nwg / NXCD, r = nwg % NXCD, xcd = wgid % NXCD, off = wgid / NXCD; wgid = (xcd < r ? xcd * (q + 1) : r * (q + 1) + (xcd - r) * q) + off; }
        const int nig = WGM * nN, gid = wgid / nig, fm = gid * WGM, gsz = (nM - fm) < WGM ? (nM - fm) : WGM;
        u.pm = fm + ((wgid % nig) % gsz); u.pn = (wgid % nig) / gsz;
        if (mix) { const int j = u.pn; u.pn = 16 * ((j >> 3) & 1) + 8 * ((j >> 4) & 1) + (j & 7); }
        return true;
    }
};

typedef f32x4 Acc[2][2][4][2];

template <class Epi>
__device__ __forceinline__ void gemm_phase(LAS unsigned char* lds, const Gemm g, const StaticOrder& S, const Epi& E) {
    const int tid = threadIdx.x, wid = __builtin_amdgcn_readfirstlane(tid >> 6), lane = tid & 63, wr = wid >> 2, wc = wid & 3, fr = lane & 15, fq = lane >> 4;
    const int K = g.K, nt = K / BK;
    unsigned voffA[2], voffB[2];
#pragma unroll
    for (int i = 0; i < 2; ++i) { int R, C; stage_rc(tid * 16 + i * 8192, R, C); const int Rb = Epi::PERM ? ((R & ~31) + perm32(R & 31)) : R;
        voffA[i] = (unsigned)(R * g.lda + C) * 2u; voffB[i] = (unsigned)(Rb * g.ldb + C) * 2u; }
    const size_t kstep = (size_t)(BK * 2);
    const size_t hstepA = (size_t)HALF * g.lda * 2, hstepB = (size_t)HALF * g.ldb * 2;
    const size_t tstepA = 2 * hstepA, tstepB = 2 * hstepB;
    const unsigned ldsw = (unsigned)wid * 1024u;
    const int aoff = lds_byte(wr * 64 + fr, fq * 8), boff = lds_byte(wc * 32 + fr, fq * 8);
#define PG8_SA(b, h) (((b) * 2 + (h)) * HTB)
#define PG8_SB(b, h) ((4 + (b) * 2 + (h)) * HTB)
#define PG8_STAGE(bufoff, gbase, voff) do { _Pragma("unroll") for (int _i = 0; _i < 2; ++_i) \
        __builtin_amdgcn_global_load_lds((const unsigned*)((const char*)(gbase) + (voff)[_i]), (LAS unsigned*)(lds + (bufoff) + ldsw + _i * 8192), 16, 0, 0); } while (0)
#define PG8_LDA(dst, b, h) do { _Pragma("unroll") for (int m = 0; m < 4; ++m) _Pragma("unroll") for (int k = 0; k < 2; ++k) dst[m][k] = *(const LAS bf16x8*)(lds + PG8_SA(b, h) + aoff + m * 2048 + k * 1024); } while (0)
#define PG8_LDB(dst, b, h) do { _Pragma("unroll") for (int n = 0; n < 2; ++n) _Pragma("unroll") for (int k = 0; k < 2; ++k) dst[n][k] = *(const LAS bf16x8*)(lds + PG8_SB(b, h) + boff + n * 2048 + k * 1024); } while (0)
#define PG8_MMA(ai, bj, At, Bt) do { __builtin_amdgcn_s_setprio(1); _Pragma("unroll") for (int m = 0; m < 4; ++m) _Pragma("unroll") for (int n = 0; n < 2; ++n) _Pragma("unroll") for (int k = 0; k < 2; ++k) \
        acc[ai][bj][m][n] = __builtin_amdgcn_mfma_f32_16x16x32_bf16(Bt[n][k], At[m][k], acc[ai][bj][m][n], 0, 0, 0); __builtin_amdgcn_s_setprio(0); } while (0)
#define PG8_WAIT_V(n) asm volatile("s_waitcnt vmcnt(" #n ")" ::: "memory")
#define PG8_WAIT_L(n) asm volatile("s_waitcnt lgkmcnt(" #n ")" ::: "memory")
#define PG8_BAR __builtin_amdgcn_s_barrier()
#define PG8_SCHED __builtin_amdgcn_sched_barrier(0)
    Unit cur, nxt; int ui = 0;
#define PG8_NEXT(i, u) (Epi::MID ? S.next((i) >> 1, u) : S.next((i), u))
#define PG8_KOFF(i) (Epi::MID ? (size_t)((i) & 1) * (size_t)K * 2 : (size_t)0)
    if (!PG8_NEXT(0, cur)) return;
    Acc acc;
#pragma unroll
    for (int a = 0; a < 2; ++a)
#pragma unroll
        for (int b = 0; b < 2; ++b)
#pragma unroll
            for (int m = 0; m < 4; ++m)
#pragma unroll
                for (int n = 0; n < 2; ++n) acc[a][b][m][n] = (f32x4){0.f, 0.f, 0.f, 0.f};
    bf16x8 At[4][2], B0[2][2], B1[2][2];
    const char* cA = (const char*)g.A + (size_t)cur.pm * tstepA + (size_t)cur.pn * g.apn + PG8_KOFF(0); const char* cB = (const char*)g.Bt + (size_t)cur.pn * tstepB + PG8_KOFF(0);
    PG8_STAGE(PG8_SB(0, 0), cB, voffB); PG8_STAGE(PG8_SB(0, 1), cB + hstepB, voffB); PG8_STAGE(PG8_SA(0, 0), cA, voffA); PG8_STAGE(PG8_SA(0, 1), cA + hstepA, voffA);
    if (wr == 1) PG8_BAR;
    PG8_WAIT_V(2); PG8_BAR;
    PG8_STAGE(PG8_SB(1, 0), cB + kstep, voffB); PG8_STAGE(PG8_SA(1, 0), cA + kstep, voffA); PG8_STAGE(PG8_SB(1, 1), cB + hstepB + kstep, voffB);
    PG8_WAIT_V(6); PG8_BAR;
    for (;;) {
        const bool has_next = PG8_NEXT(ui + 1, nxt);
        const char* nA = has_next ? (const char*)g.A + (size_t)nxt.pm * tstepA + (size_t)nxt.pn * g.apn + PG8_KOFF(ui + 1) : cA; const char* nB = has_next ? (const char*)g.Bt + (size_t)nxt.pn * tstepB + PG8_KOFF(ui + 1) : cB;
#pragma nounroll
        for (int t = 0; t < nt; t += 2) {
            const bool last = (t == nt - 2);
            const char* a1 = cA + (size_t)(t + 1) * kstep;
            const char* a2 = last ? nA : cA + (size_t)(t + 2) * kstep; const char* b2 = last ? nB : cB + (size_t)(t + 2) * kstep;
            const char* a3 = a2 + kstep; const char* b3 = b2 + kstep;
            PG8_LDB(B0, 0, 0); PG8_LDB(B1, 0, 1); PG8_SCHED; PG8_LDA(At, 0, 0); PG8_STAGE(PG8_SA(1, 1), a1 + hstepA, voffA);
            PG8_WAIT_V(8); PG8_WAIT_L(0); PG8_BAR; PG8_MMA(0, 0, At, B0); PG8_MMA(0, 1, At, B1); PG8_BAR; PG8_SCHED;
            PG8_LDA(At, 0, 1); PG8_STAGE(PG8_SB(0, 0), b2, voffB); PG8_STAGE(PG8_SB(0, 1), b2 + hstepB, voffB); PG8_STAGE(PG8_SA(0, 0), a2, voffA);
            PG8_WAIT_V(8); PG8_WAIT_L(0); PG8_BAR; PG8_MMA(1, 0, At, B0); PG8_MMA(1, 1, At, B1); PG8_BAR; PG8_SCHED;
            PG8_LDB(B0, 1, 0); PG8_LDB(B1, 1, 1); PG8_SCHED; PG8_LDA(At, 1, 0); PG8_STAGE(PG8_SA(0, 1), a2 + hstepA, voffA);
            PG8_WAIT_V(8); PG8_WAIT_L(0); PG8_BAR; PG8_MMA(0, 0, At, B0); PG8_MMA(0, 1, At, B1); PG8_BAR; PG8_SCHED;
            PG8_LDA(At, 1, 1); PG8_STAGE(PG8_SB(1, 0), b3, voffB); PG8_STAGE(PG8_SB(1, 1), b3 + hstepB, voffB); PG8_STAGE(PG8_SA(1, 0), a3, voffA);
            PG8_WAIT_V(8); PG8_WAIT_L(0); PG8_BAR; PG8_MMA(1, 0, At, B0); PG8_MMA(1, 1, At, B1); PG8_BAR; PG8_SCHED;
        }
        if (wr == 0) PG8_BAR;
        bool fin = true;
        if constexpr (Epi::MID) { if ((ui & 1) == 0) { E.mid(acc, cur, wr, wc, fr, fq); fin = false; } }
        if constexpr (!Epi::FUSED) { if (fin) E(acc, cur, wr, wc, fr, fq); }
        if (!has_next) break;
        if (fin) {
#pragma unroll
        for (int a = 0; a < 2; ++a)
#pragma unroll
            for (int b = 0; b < 2; ++b)
#pragma unroll
                for (int m = 0; m < 4; ++m)
#pragma unroll
                    for (int n = 0; n < 2; ++n) acc[a][b][m][n] = (f32x4){0.f, 0.f, 0.f, 0.f};
        }
        cur = nxt; cA = nA; cB = nB; ++ui;
        if (wr == 1) PG8_BAR;
    }
    PG8_WAIT_V(0);
    PG8_BAR;
    if constexpr (Epi::FUSED) E.fused(acc, cur, wr, wc, fr, fq, lds);
#undef PG8_NEXT
#undef PG8_KOFF
#undef PG8_SA
#undef PG8_SB
#undef PG8_STAGE
#undef PG8_LDA
#undef PG8_LDB
#undef PG8_MMA
#undef PG8_WAIT_V
#undef PG8_WAIT_L
#undef PG8_BAR
#undef PG8_SCHED
}

struct Epi1 {
    static constexpr bool PERM = true, MID = false, FUSED = false;
    bf16_t* H1; bf16_t* G; const float* cosT; const float* sinT;
    __device__ __forceinline__ void operator()(const Acc& acc, const Unit& u, int wr, int wc, int fr, int fq) const {
        const int row0 = u.pm * BM + wr * 64 + fr;
        if (u.pn < 8) {
            const float sc = (u.pn < 4) ? QSCALE : 1.0f;
            const int d0 = 16 * wc + 4 * fq;
#pragma unroll
            for (int ai = 0; ai < 2; ++ai)
#pragma unroll
                for (int m = 0; m < 4; ++m) { const int row = row0 + ai * HALF + m * 16;
                    const f32x4 cs = *(const f32x4*)(cosT + (size_t)row * 64 + d0) * sc, sn = *(const f32x4*)(sinT + (size_t)row * 64 + d0) * sc;
#pragma unroll
                    for (int bj = 0; bj < 2; ++bj) { const f32x4 v0 = acc[ai][bj][m][0], v1 = acc[ai][bj][m][1];
                        const f32x4 lo = v0 * cs - v1 * sn, hi = v1 * cs + v0 * sn;
                        bf16_t* p = H1 + (size_t)row * 4096 + u.pn * BM + bj * HALF + d0;
                        u32x2 a, b; a.x = cvt_pk_bf16(lo[0], lo[1]); a.y = cvt_pk_bf16(lo[2], lo[3]); b.x = cvt_pk_bf16(hi[0], hi[1]); b.y = cvt_pk_bf16(hi[2], hi[3]);
                        *(u32x2*)p = a; *(u32x2*)(p + 64) = b; } }
        } else if (u.pn < 16) {
            const int col0 = u.pn * BM + wc * 32 + 8 * fq;
#pragma unroll
            for (int ai = 0; ai < 2; ++ai)
#pragma unroll
                for (int m = 0; m < 4; ++m) { bf16_t* rowp = H1 + (size_t)(row0 + ai * HALF + m * 16) * 4096 + col0;
#pragma unroll
                    for (int bj = 0; bj < 2; ++bj) { const f32x4 v0 = acc[ai][bj][m][0], v1 = acc[ai][bj][m][1];
                        u32x4 w; w.x = cvt_pk_bf16(v0[0], v0[1]); w.y = cvt_pk_bf16(v0[2], v0[3]); w.z = cvt_pk_bf16(v1[0], v1[1]); w.w = cvt_pk_bf16(v1[2], v1[3]);
                        *(u32x4*)(rowp + bj * HALF) = w; } }
        } else {
            const int col0 = (u.pn - 16) * BM + wc * 32 + 8 * fq;
#pragma unroll
            for (int ai = 0; ai < 2; ++ai)
#pragma unroll
                for (int m = 0; m < 4; ++m) { bf16_t* rowp = G + (size_t)(row0 + ai * HALF + m * 16) * 4096 + col0;
#pragma unroll
                    for (int bj = 0; bj < 2; ++bj) { f32x4 v0 = acc[ai][bj][m][0], v1 = acc[ai][bj][m][1];
#pragma unroll
                        for (int j = 0; j < 4; ++j) { v0[j] = __builtin_amdgcn_rcpf(1.0f + __expf(-fmaxf(v0[j], -60.f))); v1[j] = __builtin_amdgcn_rcpf(1.0f + __expf(-fmaxf(v1[j], -60.f))); }
                        u32x4 w; w.x = cvt_pk_bf16(v0[0], v0[1]); w.y = cvt_pk_bf16(v0[2], v0[3]); w.z = cvt_pk_bf16(v1[0], v1[1]); w.w = cvt_pk_bf16(v1[2], v1[3]);
                        __builtin_nontemporal_store(w, (u32x4*)(rowp + bj * HALF)); } }
        }
    }
};
template <int ACT> struct EpiBf16 {
    static constexpr bool PERM = true, MID = false, FUSED = false;
    bf16_t* O; int ldc; int coloff; const float* scale;
    __device__ __forceinline__ void operator()(const Acc& acc, const Unit& u, int wr, int wc, int fr, int fq) const {
        const int row0 = u.pm * BM + wr * 64 + fr, col0 = u.pn * BM + wc * 32 + 8 * fq;
#pragma unroll
        for (int ai = 0; ai < 2; ++ai)
#pragma unroll
            for (int m = 0; m < 4; ++m) { bf16_t* rowp = O + (size_t)(row0 + ai * HALF + m * 16) * ldc + coloff + col0;
#pragma unroll
                for (int bj = 0; bj < 2; ++bj) { f32x4 v0 = acc[ai][bj][m][0], v1 = acc[ai][bj][m][1];
                    if (ACT == 1) {
#pragma unroll
                        for (int j = 0; j < 4; ++j) { const float a = fmaxf(v0[j], 0.f), b = fmaxf(v1[j], 0.f); v0[j] = a * a; v1[j] = b * b; } }
                    if (ACT == 2) { v0 = v0 * *(const f32x4*)(scale + col0 + bj * HALF); v1 = v1 * *(const f32x4*)(scale + col0 + bj * HALF + 4); }
                    u32x4 w; w.x = cvt_pk_bf16(v0[0], v0[1]); w.y = cvt_pk_bf16(v0[2], v0[3]); w.z = cvt_pk_bf16(v1[0], v1[1]); w.w = cvt_pk_bf16(v1[2], v1[3]);
                    *(u32x4*)(rowp + bj * HALF) = w; }
                if (ACT == 2) asm volatile("" ::: "memory"); }
    }
};
struct Epi3 {
    static constexpr bool PERM = true, MID = true, FUSED = false;
    bf16_t* O; const bf16_t* G;
    __device__ __forceinline__ void mid(Acc& acc, const Unit& u, int wr, int wc, int fr, int fq) const {
        const int row0 = u.pm * BM + wr * 64 + fr, col0 = u.pn * BM + wc * 32 + 8 * fq;
#pragma unroll
        for (int ai = 0; ai < 2; ++ai)
#pragma unroll
            for (int m = 0; m < 4; ++m) { const bf16_t* gp = G + (size_t)(row0 + ai * HALF + m * 16) * 4096 + col0;
#pragma unroll
                for (int bj = 0; bj < 2; ++bj) { const u32x4 a = __builtin_nontemporal_load((const u32x4*)(gp + bj * HALF)), b = *(const u32x4*)(gp + 2048 + bj * HALF);
                    f32x4 r0, r1;
                    r0[0] = bf_lo(a.x) * __builtin_amdgcn_rcpf(bf_lo(b.x)); r0[1] = bf_hi(a.x) * __builtin_amdgcn_rcpf(bf_hi(b.x)); r0[2] = bf_lo(a.y) * __builtin_amdgcn_rcpf(bf_lo(b.y)); r0[3] = bf_hi(a.y) * __builtin_amdgcn_rcpf(bf_hi(b.y));
                    r1[0] = bf_lo(a.z) * __builtin_amdgcn_rcpf(bf_lo(b.z)); r1[1] = bf_hi(a.z) * __builtin_amdgcn_rcpf(bf_hi(b.z)); r1[2] = bf_lo(a.w) * __builtin_amdgcn_rcpf(bf_lo(b.w)); r1[3] = bf_hi(a.w) * __builtin_amdgcn_rcpf(bf_hi(b.w));
                    acc[ai][bj][m][0] = acc[ai][bj][m][0] * r0; acc[ai][bj][m][1] = acc[ai][bj][m][1] * r1; }
                asm volatile("" ::: "memory"); }
    }
    __device__ __forceinline__ void operator()(const Acc& acc, const Unit& u, int wr, int wc, int fr, int fq) const {
        const int row0 = u.pm * BM + wr * 64 + fr, col0 = u.pn * BM + wc * 32 + 8 * fq;
#pragma unroll
        for (int ai = 0; ai < 2; ++ai)
#pragma unroll
            for (int m = 0; m < 4; ++m) { const size_t row = (size_t)(row0 + ai * HALF + m * 16); const bf16_t* gp = G + row * 4096 + 2048 + col0; bf16_t* rowp = O + row * DM + col0;
#pragma unroll
                for (int bj = 0; bj < 2; ++bj) { const u32x4 b = __builtin_nontemporal_load((const u32x4*)(gp + bj * HALF)); const f32x4 v0 = acc[ai][bj][m][0], v1 = acc[ai][bj][m][1];
                    u32x4 w; w.x = cvt_pk_bf16(v0[0] * bf_lo(b.x), v0[1] * bf_hi(b.x)); w.y = cvt_pk_bf16(v0[2] * bf_lo(b.y), v0[3] * bf_hi(b.y));
                    w.z = cvt_pk_bf16(v1[0] * bf_lo(b.z), v1[1] * bf_hi(b.z)); w.w = cvt_pk_bf16(v1[2] * bf_lo(b.w), v1[3] * bf_hi(b.w));
                    *(u32x4*)(rowp + bj * HALF) = w; }
                asm volatile("" ::: "memory"); }
    }
};
struct EpiRes {
    static constexpr bool PERM = false, MID = false, FUSED = false;
    const float* base; float* out;
    __device__ __forceinline__ void operator()(const Acc& acc, const Unit& u, int wr, int wc, int fr, int fq) const {
        const int row0 = u.pm * BM + wr * 64 + fr, col0 = u.pn * BM + wc * 32 + 4 * fq;
#pragma unroll
        for (int ai = 0; ai < 2; ++ai)
#pragma unroll
            for (int m = 0; m < 4; ++m) { const size_t off = (size_t)(row0 + ai * HALF + m * 16) * DM + col0;
#pragma unroll
                for (int bj = 0; bj < 2; ++bj)
#pragma unroll
                    for (int n = 0; n < 2; ++n) { const f32x4 bs = *(const f32x4*)(base + off + bj * HALF + n * 16); *(f32x4*)(out + off + bj * HALF + n * 16) = bs * ALPHA + acc[ai][bj][m][n]; } }
    }
};
template <bool BASE_BF16> struct EpiResLn {
    static constexpr bool PERM = false, MID = false, FUSED = true;
    const float* base; const bf16_t* baseb; float* out; bf16_t* xb; const float* gam; const float* bet; float* stats; unsigned* cnt;
    __device__ __forceinline__ void operator()(const Acc&, const Unit&, int, int, int, int) const {}
    __device__ __forceinline__ void fused(Acc& acc, const Unit& u, int wr, int wc, int fr, int fq, LAS unsigned char* lds) const {
        const int row0 = u.pm * BM + wr * 64 + fr, col0 = u.pn * BM + wc * 32 + 4 * fq;
        LAS float* Pst = (LAS float*)lds;
#pragma unroll
        for (int ai = 0; ai < 2; ++ai)
#pragma unroll
            for (int m = 0; m < 4; ++m) { const size_t off = (size_t)(row0 + ai * HALF + m * 16) * DM + col0; float s = 0.f, q = 0.f;
#pragma unroll
                for (int bj = 0; bj < 2; ++bj)
#pragma unroll
                    for (int n = 0; n < 2; ++n) { f32x4 bs; if (BASE_BF16) { const u32x2 wb = *(const u32x2*)(baseb + off + bj * HALF + n * 16); bs = (f32x4){bf_lo(wb.x), bf_hi(wb.x), bf_lo(wb.y), bf_hi(wb.y)}; } else bs = __builtin_nontemporal_load((const f32x4*)(base + off + bj * HALF + n * 16));
                        const f32x4 v = bs * ALPHA + acc[ai][bj][m][n]; acc[ai][bj][m][n] = v;
                        s += (v[0] + v[1]) + (v[2] + v[3]); q += (v[0] * v[0] + v[1] * v[1]) + (v[2] * v[2] + v[3] * v[3]); }
                s += __shfl_xor(s, 16); s += __shfl_xor(s, 32); q += __shfl_xor(q, 16); q += __shfl_xor(q, 32);
                if (fq == 0) { const int rl = ai * HALF + wr * 64 + m * 16 + fr; Pst[(rl * 4 + wc) * 2] = s; Pst[(rl * 4 + wc) * 2 + 1] = q; }
                asm volatile("" ::: "memory"); }
        __syncthreads();
        if (threadIdx.x < 256) { const int rl = threadIdx.x; float s = 0.f, q = 0.f;
#pragma unroll
            for (int w = 0; w < 4; ++w) { s += Pst[(rl * 4 + w) * 2]; q += Pst[(rl * 4 + w) * 2 + 1]; }
            unsigned long long* st = (unsigned long long*)stats + ((size_t)(u.pm * BM + rl) * 8 + u.pn);
            __hip_atomic_store(st, ((unsigned long long)__float_as_uint(q) << 32) | __float_as_uint(s), __ATOMIC_RELAXED, __HIP_MEMORY_SCOPE_AGENT); }
        asm volatile("s_waitcnt vmcnt(0)" ::: "memory");
        __syncthreads();
        if (threadIdx.x == 0) { unsigned* c = cnt + 64 * u.pm; (void)xb_add(c, 1u); unsigned sp = 0u;
            while (xb_ld(c) < 8u) { __builtin_amdgcn_s_sleep(1); if (++sp > XB_SPIN_CAP) break; } }
        __syncthreads();
        LAS float* Sst = (LAS float*)(lds + 8192);
        if (threadIdx.x < 256) { const int rl = threadIdx.x; const unsigned long long* st = (const unsigned long long*)stats + (size_t)(u.pm * BM + rl) * 8; float s = 0.f, q = 0.f;
#pragma unroll
            for (int t = 0; t < 8; ++t) { const unsigned long long v = __hip_atomic_load(st + t, __ATOMIC_RELAXED, __HIP_MEMORY_SCOPE_AGENT); s += __uint_as_float((unsigned)v); q += __uint_as_float((unsigned)(v >> 32)); }
            const float mean = s * (1.0f / DM); const float var = fmaxf(q * (1.0f / DM) - mean * mean, 0.f);
            Sst[rl * 2] = mean; Sst[rl * 2 + 1] = 1.0f / sqrtf(var + LN_EPS); }
        __syncthreads();
#pragma unroll
        for (int ai = 0; ai < 2; ++ai)
#pragma unroll
            for (int m = 0; m < 4; ++m) { const int row = row0 + ai * HALF + m * 16; const size_t off = (size_t)row * DM + col0;
                const int rl = ai * HALF + wr * 64 + m * 16 + fr; const float mean = Sst[rl * 2], rstd = Sst[rl * 2 + 1];
#pragma unroll
                for (int bj = 0; bj < 2; ++bj)
#pragma unroll
                    for (int n = 0; n < 2; ++n) { const int c = col0 + bj * HALF + n * 16; const f32x4 gg = *(const f32x4*)(gam + c), bb = *(const f32x4*)(bet + c);
                        const f32x4 y = (acc[ai][bj][m][n] - mean) * rstd * gg + bb; if (out) __builtin_nontemporal_store(y, (f32x4*)(out + off + bj * HALF + n * 16));
                        if (xb) { u32x2 wv; wv.x = cvt_pk_bf16(y[0], y[1]); wv.y = cvt_pk_bf16(y[2], y[3]); *(u32x2*)(xb + off + bj * HALF + n * 16) = wv; } }
                asm volatile("" ::: "memory"); }
    }
};
}

__device__ __forceinline__ int rope_permd(int d) { return 8 * ((d & 63) >> 2) + 4 * (d >> 6) + (d & 3); }
__device__ __forceinline__ void transpose_item(const float* W, int N, bf16_t* WT, int ldw, int coloff, int row_off, bool rope, LAS float* scr, int kb, int nb, int lane, const float* rscale = nullptr) {
    const int k0 = 64 * kb, n0 = 64 * nb;
    const int lk = lane >> 4, n4 = 4 * (lane & 15);
    f32x4 tv[16];
#pragma unroll
    for (int i = 0; i < 16; ++i) tv[i] = __builtin_nontemporal_load((const f32x4*)(W + (size_t)(k0 + 4 * i + lk) * N + n0 + n4));
#pragma unroll
    for (int i = 0; i < 16; ++i) { const int k = 4 * i + lk; *(LAS f32x4*)(scr + k * 64 + (n4 ^ (4 * (k >> 3)))) = tv[i]; }
    LDS_WAIT(); asm volatile("" ::: "memory");
    const int c = lane & 7;
#pragma unroll
    for (int j = 0; j < 8; ++j) { const int n = (lane >> 3) + 8 * j; const LAS float* s = scr + (8 * c) * 64 + (n ^ (4 * c));
        const float rs = rscale ? rscale[n0 + n] : 1.0f;
        u32x4 o; o.x = cvt_pk_bf16(s[0 * 64] * rs, s[1 * 64] * rs); o.y = cvt_pk_bf16(s[2 * 64] * rs, s[3 * 64] * rs); o.z = cvt_pk_bf16(s[4 * 64] * rs, s[5 * 64] * rs); o.w = cvt_pk_bf16(s[6 * 64] * rs, s[7 * 64] * rs);
        const int ncol = n0 + n; const int drow = (rope && ncol < 2048) ? ((ncol & ~127) + rope_permd(ncol & 127)) : ncol;
        *(u32x4*)(WT + (size_t)(row_off + drow) * ldw + coloff + k0 + 8 * c) = o; }
    LDS_WAIT(); asm volatile("" ::: "memory");
}

struct Ptrs {
    const float *x, *w_in, *w_pool, *pool_scale, *w_ba, *w_bb, *w_out, *ln1g, *ln1b, *w_ff1, *w_ff2, *ln2g, *ln2b; const int* pos;
    float* out; unsigned char* ws;
};

template <bool late> __device__ __forceinline__ void p0_prologue(const Ptrs& P, LAS unsigned char* lds, int G, int bid) {
    const int tid = threadIdx.x, lane = tid & 63, wave = __builtin_amdgcn_readfirstlane(tid >> 6);
    LAS float* scr = (LAS float*)(lds + wave * 16384);
    const int gw = bid * 8 + wave, NGW = G * 8;
    bf16_t* Bt1 = (bf16_t*)(P.ws + WS_BT1); bf16_t* Bt3 = (bf16_t*)(P.ws + WS_BT3); bf16_t* Bt4 = (bf16_t*)(P.ws + WS_BT4); bf16_t* Bt5 = (bf16_t*)(P.ws + WS_BT5); bf16_t* Bt6 = (bf16_t*)(P.ws + WS_BT6); bf16_t* WpT = (bf16_t*)(P.ws + WS_WPT);
    constexpr int I_IN = (DM / 64) * (IW / 64), I_PL = 4 * (256 / 64) * (256 / 64), I_BA = (AW / 64) * (DM / 64), I_OUT = (DM / 64) * (DM / 64), I_F1 = (DM / 64) * (FF / 64), I_F2 = (FF / 64) * (DM / 64);
    constexpr int NITEMS = late ? (2 * I_BA + I_OUT + I_F1 + I_F2) : (I_IN + I_PL);
    for (int it = gw; it < NITEMS; it += NGW) {
        int r = it;
        if (late) {
            if (r < I_BA) { transpose_item(P.w_ba, DM, Bt3, 2048, 0, 0, false, scr, r / (DM / 64), r % (DM / 64), lane); continue; } r -= I_BA;
            if (r < I_BA) { transpose_item(P.w_bb, DM, Bt3, 2048, 1024, 0, false, scr, r / (DM / 64), r % (DM / 64), lane); continue; } r -= I_BA;
            if (r < I_OUT) { transpose_item(P.w_out, DM, Bt4, DM, 0, 0, false, scr, r / (DM / 64), r % (DM / 64), lane); continue; } r -= I_OUT;
            if (r < I_F1) { transpose_item(P.w_ff1, FF, Bt5, DM, 0, 0, false, scr, r / (FF / 64), r % (FF / 64), lane); continue; } r -= I_F1;
            transpose_item(P.w_ff2, DM, Bt6, FFP, 0, 0, false, scr, r / (DM / 64), r % (DM / 64), lane); continue; }
        if (r < I_IN) { transpose_item(P.w_in, IW, Bt1, DM, 0, 0, true, scr, r / (IW / 64), r % (IW / 64), lane); continue; } r -= I_IN;
        { const int g = r / 16, q = r % 16; transpose_item(P.w_pool + (size_t)g * 65536, 256, WpT, 256, 0, g * 256, false, scr, q / 4, q % 4, lane, P.pool_scale + g * 256); }
    }
    if (late) return;
    const int gt = bid * 512 + tid, NGT = G * 512;
    bf16_t* xb = (bf16_t*)(P.ws + WS_XB);
    const int vcu0 = (G % 8 == 0) ? (bid % 8) * (G / 8) + bid / 8 : bid; const int per = (S * DM / 8) / G;
    for (int i = vcu0 * per + tid; i < (vcu0 + 1) * per; i += 512) { const f32x4 a = __builtin_nontemporal_load((const f32x4*)(P.x + (size_t)i * 8)), b = __builtin_nontemporal_load((const f32x4*)(P.x + (size_t)i * 8 + 4));
        u32x4 w; w.x = cvt_pk_bf16(a[0], a[1]); w.y = cvt_pk_bf16(a[2], a[3]); w.z = cvt_pk_bf16(b[0], b[1]); w.w = cvt_pk_bf16(b[2], b[3]); *(u32x4*)(xb + (size_t)i * 8) = w; }
    float* cosT = (float*)(P.ws + WS_COS); float* sinT = (float*)(P.ws + WS_SIN);
    const double invf_rev = exp(-(double)(gt & 63) * (9.210340371976184 / 64.0)) * 0.15915494309189535;
    for (int i = gt; i < S * 64; i += NGT) { const int t = i >> 6, f = i & 63;
        const double invf = (NGT & 63) ? exp(-(double)f * (9.210340371976184 / 64.0)) * 0.15915494309189535 : invf_rev; const double rev = (double)P.pos[t] * invf; const float fr = (float)(rev - floor(rev));
        cosT[i] = __builtin_amdgcn_cosf(fr); sinT[i] = __builtin_amdgcn_sinf(fr); }
}

__device__ __forceinline__ unsigned off_k(unsigned row, unsigned ch) { return 256u * row + 16u * (ch ^ (row & 15u)); }
__device__ __forceinline__ unsigned off_v(unsigned row, unsigned ch) { return 256u * row + 16u * (ch ^ ((row & 7u) << 1)); }
#define VTR(dst, addr, imm) asm volatile("ds_read_b64_tr_b16 %0, %1 offset:%c2" : "=&v"(dst) : "v"(addr), "i"(imm) : "memory")

__device__ __forceinline__ void attn_phase(const Ptrs& P, LAS unsigned char* lds, int G, int bid) {
    const int tid = threadIdx.x, lane = tid & 63, w = __builtin_amdgcn_readfirstlane(tid >> 6), ql = lane & 15, g = lane >> 4;
    const bf16_t* H1 = (const bf16_t*)(P.ws + WS_H1);
    bf16_t* OP = (bf16_t*)(P.ws + WS_OP); float* LSE = (float*)(P.ws + WS_LSE);
    LAS unsigned char* Ks = lds; LAS unsigned char* Vs = lds + 65536;
    const unsigned vbase = (unsigned)(size_t)Vs;
    const int srow = tid >> 4, sch = tid & 15;
    const unsigned soffK = off_k((unsigned)srow, (unsigned)sch), soffV = off_v((unsigned)srow, (unsigned)sch);
    unsigned vb[8];
    { const unsigned q4 = (unsigned)(lane & 15) >> 2, p4 = (unsigned)lane & 3;
#pragma unroll
      for (int c = 0; c < 8; ++c) vb[c] = vbase + off_v(16u * (unsigned)w + 4u * (unsigned)g + q4, 2u * c + (p4 >> 1)) + 8u * (p4 & 1u); }
#define ATT_DECODE(u_, p_, h_, r_, n_, dil_) const int p_ = (u_) >> 9, h_ = ((u_) & 511) >> 6; const int dil_ = 1 << (2 * p_); const int r_ = ((u_) & 63) >> (6 - 2 * p_), n_ = ((u_) & 63) & ((64 >> (2 * p_)) - 1)
    u32x4 kreg[8], vreg[8];
#define ATT_LOAD_TILE(dst, coloff, n_, dil_, r_, h_) do { _Pragma("unroll") for (int i = 0; i < 8; ++i) { dst[i] = (u32x4){0u, 0u, 0u, 0u}; \
        if (!((n_) == 0 && i < 4)) dst[i] = *(const u32x4*)(H1 + (size_t)((128 * ((n_) - 1) + srow + 32 * i) * (dil_) + (r_)) * 4096 + (coloff) + (h_) * 128 + sch * 8); } } while (0)
    { ATT_DECODE(bid, p, h, r, n, dil);
      if (bid < 3 * 512) { ATT_LOAD_TILE(kreg, 1024, n, dil, r, h); ATT_LOAD_TILE(vreg, 2048, n, dil, r, h); } }
    for (int u = bid; u < 3 * 512; u += G) {
        ATT_DECODE(u, p, h, r, n, dil);
#pragma unroll
        for (int i = 0; i < 8; ++i) *(LAS u32x4*)(Ks + soffK + 8192 * i) = kreg[i];
        const bool has_next = (u + G < 3 * 512);
        ATT_DECODE(u + G, p2, h2, r2, n2, dil2);
        if (has_next) ATT_LOAD_TILE(kreg, 1024, n2, dil2, r2, h2);
        const int qpos = (128 * n + 16 * w + ql) * dil + r;
        bf16x8 qf[4];
#pragma unroll
        for (int ks = 0; ks < 4; ++ks) qf[ks] = *(const bf16x8*)(H1 + (size_t)qpos * 4096 + h * 128 + 32 * ks + 8 * g);
        __syncthreads();
        f32x4 s[9];
#pragma unroll
        for (int t = 0; t < 9; ++t) { s[t] = (f32x4){0.f, 0.f, 0.f, 0.f};
#pragma unroll
            for (int ks = 0; ks < 4; ++ks) { const bf16x8 kf = *(const LAS bf16x8*)(Ks + off_k(16 * (w + t) + ql, 4 * ks + g)); s[t] = __builtin_amdgcn_mfma_f32_16x16x32_bf16(kf, qf[ks], s[t], 0, 0, 0); } }
        const float NEG = -INFINITY;
#pragma unroll
        for (int j = 0; j < 4; ++j) { const int kk = 4 * g + j; if (kk < ql) s[0][j] = NEG; if (kk > ql) s[8][j] = NEG; }
        if (n == 0) {
#pragma unroll
            for (int t = 0; t < 8; ++t) if (w + t < 8) s[t] = (f32x4){NEG, NEG, NEG, NEG}; }
        float mx = NEG;
#pragma unroll
        for (int t = 0; t < 9; ++t) mx = fmaxf(mx, fmaxf(fmaxf(s[t][0], s[t][1]), fmaxf(s[t][2], s[t][3])));
        mx = fmaxf(mx, __shfl_xor(mx, 16)); mx = fmaxf(mx, __shfl_xor(mx, 32));
        float l = 0.f;
#pragma unroll
        for (int t = 0; t < 9; ++t) {
#pragma unroll
            for (int j = 0; j < 4; ++j) { const float e = __builtin_amdgcn_exp2f(s[t][j] - mx); s[t][j] = e; l += e; } }
        l += __shfl_xor(l, 16); l += __shfl_xor(l, 32);
#pragma unroll
        for (int i = 0; i < 8; ++i) *(LAS u32x4*)(Vs + soffV + 8192 * i) = vreg[i];
        __syncthreads();
        f32x4 o[8];
#pragma unroll
        for (int c = 0; c < 8; ++c) o[c] = (f32x4){0.f, 0.f, 0.f, 0.f};
#pragma unroll
        for (int kp = 0; kp < 5; ++kp) { const int t0 = 2 * kp, t1 = (2 * kp + 1 < 9) ? 2 * kp + 1 : 2 * kp;
            bf16x8 pf; { const unsigned a = cvt_pk_bf16(s[t0][0], s[t0][1]), b = cvt_pk_bf16(s[t0][2], s[t0][3]);
                unsigned c2 = 0u, d2 = 0u; if (2 * kp + 1 < 9) { c2 = cvt_pk_bf16(s[t1][0], s[t1][1]); d2 = cvt_pk_bf16(s[t1][2], s[t1][3]); }
                const u32x4 pw = (u32x4){a, b, c2, d2}; pf = __builtin_bit_cast(bf16x8, pw); }
            s16x4 lo[8], hi[8];
#pragma unroll
            for (int c = 0; c < 8; ++c) { VTR(lo[c], vb[c], 4096 * t0); VTR(hi[c], vb[c], 4096 * t1); }
            LDS_WAIT(); __builtin_amdgcn_sched_barrier(0);
#pragma unroll
            for (int c = 0; c < 8; ++c) { const bf16x8 vf = (bf16x8){lo[c][0], lo[c][1], lo[c][2], lo[c][3], hi[c][0], hi[c][1], hi[c][2], hi[c][3]};
                o[c] = __builtin_amdgcn_mfma_f32_16x16x32_bf16(vf, pf, o[c], 0, 0, 0); }
        }
        if (has_next) ATT_LOAD_TILE(vreg, 2048, n2, dil2, r2, h2);
        const float inv = 1.0f / l;
        LAS unsigned char* ost = lds + OST_OFF + w * 2304;
        const int orow = lane >> 2, oseg = lane & 3;
        bf16_t* op = OP + (size_t)p * S * AW + (size_t)((128 * n + 16 * w + orow) * dil + r) * AW + h * 128 + 16 * oseg;
#pragma unroll
        for (int hf = 0; hf < 2; ++hf) {
#pragma unroll
            for (int cc = 0; cc < 4; ++cc) { const int c = 4 * hf + cc; u32x2 wv; wv.x = cvt_pk_bf16(o[c][0] * inv, o[c][1] * inv); wv.y = cvt_pk_bf16(o[c][2] * inv, o[c][3] * inv);
                *(LAS u32x2*)(ost + ql * 144 + cc * 32 + g * 8) = wv; }
            asm volatile("" ::: "memory");
            const u32x4 r0 = *(const LAS u32x4*)(ost + orow * 144 + oseg * 32), r1 = *(const LAS u32x4*)(ost + orow * 144 + oseg * 32 + 16);
            asm volatile("" ::: "memory");
            *(u32x4*)(op + 64 * hf) = r0; *(u32x4*)(op + 64 * hf + 8) = r1;
        }
        if (g == 0) LSE[((size_t)p * S + qpos) * NH + h] = mx + __builtin_amdgcn_logf(l);
    }
    __syncthreads();
    bf16_t* Pp = (bf16_t*)(P.ws + WS_P);
    const int gt = bid * 512 + tid, NGT = G * 512;
    for (int i = gt; i < (S / 32) * 128; i += NGT) { const int ch = i & 127, t0 = (i >> 7) * 32; const int win = 2 << (ch >> 5);
        const bf16_t* src = H1 + (size_t)t0 * 4096 + 3072 + ch * 8;
        float ws8[8];
#pragma unroll
        for (int e = 0; e < 8; ++e) ws8[e] = 0.f;
        for (int j = 1; j <= win; ++j) if (t0 - j >= 0) { const u32x4 y = *(const u32x4*)(src - (size_t)j * 4096);
            ws8[0] += bf_lo(y.x); ws8[1] += bf_hi(y.x); ws8[2] += bf_lo(y.y); ws8[3] += bf_hi(y.y); ws8[4] += bf_lo(y.z); ws8[5] += bf_hi(y.z); ws8[6] += bf_lo(y.w); ws8[7] += bf_hi(y.w); }
#pragma unroll 8
        for (int s = 0; s < 32; ++s) { const int t = t0 + s; const u32x4 x0 = *(const u32x4*)(src + (size_t)s * 4096);
            u32x4 y = (u32x4){0u, 0u, 0u, 0u}; if (t - win >= 0) y = *(const u32x4*)(src + (size_t)(s - win) * 4096);
            const float xs[8] = {bf_lo(x0.x), bf_hi(x0.x), bf_lo(x0.y), bf_hi(x0.y), bf_lo(x0.z), bf_hi(x0.z), bf_lo(x0.w), bf_hi(x0.w)};
            const float ys[8] = {bf_lo(y.x), bf_hi(y.x), bf_lo(y.y), bf_hi(y.y), bf_lo(y.z), bf_hi(y.z), bf_lo(y.w), bf_hi(y.w)};
            const int cnt = (t + 1 < win) ? t + 1 : win; const float ic = 1.0f / (float)cnt;
            float pv[8];
#pragma unroll
            for (int e = 0; e < 8; ++e) { ws8[e] += xs[e] - ys[e]; pv[e] = ws8[e] * ic - xs[e]; }
            u32x4 wv; wv.x = cvt_pk_bf16(pv[0], pv[1]); wv.y = cvt_pk_bf16(pv[2], pv[3]); wv.z = cvt_pk_bf16(pv[4], pv[5]); wv.w = cvt_pk_bf16(pv[6], pv[7]);
            *(u32x4*)(Pp + (size_t)t * AW + ch * 8) = wv; }
    }
}

__device__ __forceinline__ void combine_phase(const Ptrs& P, int G, int bid) {
    const bf16_t* OP = (const bf16_t*)(P.ws + WS_OP); const float* LSE = (const float*)(P.ws + WS_LSE); bf16_t* A3 = (bf16_t*)(P.ws + WS_A3);
    int start, cnt;
    if (G == 256) { start = (bid < 128) ? bid * 2048 : 128 * 2048 + (bid - 128) * 6144; cnt = (bid < 128) ? 2048 : 6144; }
    else { const int per = (S * 128 + G - 1) / G; start = bid * per; cnt = (start + per <= S * 128) ? per : (S * 128 > start ? S * 128 - start : 0); }
    for (int b0 = threadIdx.x; b0 < cnt; b0 += 4 * 512) {
        u32x4 a[4], b[4], c[4]; float l0[4], l1[4], l2[4];
#pragma unroll
        for (int k = 0; k < 4; ++k) { const int ii = b0 + 512 * k; const int i = start + (ii < cnt ? ii : b0); const int t = i >> 7, ch = i & 127, h = ch >> 4;
            l0[k] = LSE[((size_t)0 * S + t) * NH + h]; l1[k] = LSE[((size_t)1 * S + t) * NH + h]; l2[k] = LSE[((size_t)2 * S + t) * NH + h];
            const size_t off = (size_t)t * AW + ch * 8;
            a[k] = __builtin_nontemporal_load((const u32x4*)(OP + off)); b[k] = __builtin_nontemporal_load((const u32x4*)(OP + (size_t)S * AW + off)); c[k] = __builtin_nontemporal_load((const u32x4*)(OP + 2 * (size_t)S * AW + off)); }
#pragma unroll
        for (int k = 0; k < 4; ++k) { const int ii = b0 + 512 * k; if (ii < cnt) { const int i = start + ii; const int t = i >> 7, ch = i & 127;
            const float m = fmaxf(l0[k], fmaxf(l1[k], l2[k])); float w0 = __builtin_amdgcn_exp2f(l0[k] - m), w1 = __builtin_amdgcn_exp2f(l1[k] - m), w2 = __builtin_amdgcn_exp2f(l2[k] - m);
            const float is = 1.0f / (w0 + w1 + w2); w0 *= is; w1 *= is; w2 *= is;
            u32x4 wv;
            wv.x = cvt_pk_bf16(w0 * bf_lo(a[k].x) + w1 * bf_lo(b[k].x) + w2 * bf_lo(c[k].x), w0 * bf_hi(a[k].x) + w1 * bf_hi(b[k].x) + w2 * bf_hi(c[k].x));
            wv.y = cvt_pk_bf16(w0 * bf_lo(a[k].y) + w1 * bf_lo(b[k].y) + w2 * bf_lo(c[k].y), w0 * bf_hi(a[k].y) + w1 * bf_hi(b[k].y) + w2 * bf_hi(c[k].y));
            wv.z = cvt_pk_bf16(w0 * bf_lo(a[k].z) + w1 * bf_lo(b[k].z) + w2 * bf_lo(c[k].z), w0 * bf_hi(a[k].z) + w1 * bf_hi(b[k].z) + w2 * bf_hi(c[k].z));
            wv.w = cvt_pk_bf16(w0 * bf_lo(a[k].w) + w1 * bf_lo(b[k].w) + w2 * bf_lo(c[k].w), w0 * bf_hi(a[k].w) + w1 * bf_hi(b[k].w) + w2 * bf_hi(c[k].w));
            *(u32x4*)(A3 + (size_t)t * DM + ch * 8) = wv; } }
    }
}

__device__ __forceinline__ float wave_sum(float v) {
#pragma unroll
    for (int o = 1; o < 64; o <<= 1) v += __shfl_xor(v, o);
    return v;
}
__device__ __forceinline__ void ln_phase(float* X, const float* gam, const float* bet, bf16_t* xb, int G, int bid) {
    const int lane = threadIdx.x & 63, wave = threadIdx.x >> 6; const int gw = bid * 8 + wave, NGW = G * 8;
    for (int row = gw; row < S; row += NGW) { f32x4* xr = (f32x4*)(X + (size_t)row * DM) + lane;
        f32x4 v[8]; float s = 0.f;
#pragma unroll
        for (int j = 0; j < 8; ++j) { v[j] = xr[64 * j]; s += (v[j][0] + v[j][1]) + (v[j][2] + v[j][3]); }
        const float mean = wave_sum(s) * (1.0f / DM); float s2 = 0.f;
#pragma unroll
        for (int j = 0; j < 8; ++j) { v[j] = v[j] - mean; s2 += (v[j][0] * v[j][0] + v[j][1] * v[j][1]) + (v[j][2] * v[j][2] + v[j][3] * v[j][3]); }
        const float rstd = 1.0f / sqrtf(wave_sum(s2) * (1.0f / DM) + LN_EPS);
#pragma unroll
        for (int j = 0; j < 8; ++j) { const f32x4 gg = *((const f32x4*)gam + lane + 64 * j), bb = *((const f32x4*)bet + lane + 64 * j); const f32x4 y = v[j] * rstd * gg + bb; xr[64 * j] = y;
            if (xb) { u32x2 wv; wv.x = cvt_pk_bf16(y[0], y[1]); wv.y = cvt_pk_bf16(y[2], y[3]); *((u32x2*)(xb + (size_t)row * DM) + lane + 64 * j) = wv; } }
    }
}

struct Args { const void* in[14]; float* out; unsigned char* ws; int ph_lo, ph_hi; };
__global__ void __launch_bounds__(512, 2) mega_fwd(Args a) {
    extern __shared__ __attribute__((aligned(16))) unsigned char lds_raw[];
    LAS unsigned char* lds = (LAS unsigned char*)lds_raw;
    Ptrs P;
    P.x = (const float*)a.in[0]; P.pos = (const int*)a.in[1]; P.w_in = (const float*)a.in[2]; P.w_pool = (const float*)a.in[3]; P.pool_scale = (const float*)a.in[4];
    P.w_ba = (const float*)a.in[5]; P.w_bb = (const float*)a.in[6]; P.w_out = (const float*)a.in[7]; P.ln1g = (const float*)a.in[8]; P.ln1b = (const float*)a.in[9];
    P.w_ff1 = (const float*)a.in[10]; P.w_ff2 = (const float*)a.in[11]; P.ln2g = (const float*)a.in[12]; P.ln2b = (const float*)a.in[13]; P.out = a.out; P.ws = a.ws;
    const int G = gridDim.x, bid = blockIdx.x;
    const int lo = a.ph_lo, hi = a.ph_hi;
    unsigned char* ws = a.ws;
#ifndef PHASE_MASK
#define PHASE_MASK 0x3ff
#endif
#define IN(k) (((PHASE_MASK >> (k)) & 1) && lo <= (k) && (k) < hi)
    volatile LAS unsigned* bst = (volatile LAS unsigned*)(lds + 131072 + 64);
    if (threadIdx.x < 2) bst[threadIdx.x] = 0u;
    __syncthreads();
    XcdBarrier xbar; xbar.bar = (unsigned*)ws; xbar.x = 0; xbar.st = bst;
    xbar = xcd_barrier_post((unsigned*)ws, bst);
#define SEAM(k) do { if (IN(k) && IN((k) + 1)) { if (hi > NPH) cg::this_grid().sync();   else xcd_barrier(xbar); } } while (0)
#ifndef REP_MASK
#define REP_MASK 0
#endif
    if (IN(0)) { p0_prologue<false>(P, lds, G, bid); __syncthreads(); }
    SEAM(0);
    if (REP_MASK & 1024) { xcd_barrier(xbar); xcd_barrier(xbar); xcd_barrier(xbar); xcd_barrier(xbar); }
    if (IN(1)) {
        pg8::Gemm g{(const bf16_t*)(ws + WS_XB), (const bf16_t*)(ws + WS_BT1), DM, DM, DM, 0}; pg8::StaticOrder so; so.init(S, IW, G, bid, 1);
        pg8::Epi1 E{(bf16_t*)(ws + WS_H1), (bf16_t*)(ws + WS_G), (const float*)(ws + WS_COS), (const float*)(ws + WS_SIN)};
        pg8::gemm_phase(lds, g, so, E);
        if (REP_MASK & 2) { __syncthreads(); pg8::gemm_phase(lds, g, so, E); }
    }
    SEAM(1);
    if (IN(2)) { const int vcu = (G % 8 == 0) ? (bid % 8) * (G / 8) + bid / 8 : bid;
        attn_phase(P, lds, G, vcu); if (REP_MASK & 4) { __syncthreads(); attn_phase(P, lds, G, vcu); } }
    SEAM(2);
    if (IN(3)) {
        pg8::Gemm g{(const bf16_t*)(ws + WS_P), (const bf16_t*)(ws + WS_WPT), AW, 256, 256, 512}; pg8::StaticOrder so; so.init(S, 1024, G, bid);
        pg8::EpiBf16<0> E{(bf16_t*)(ws + WS_A3), DM, 1024, nullptr};
        pg8::gemm_phase(lds, g, so, E);
        combine_phase(P, G, bid);
        p0_prologue<true>(P, lds, G, bid);
    }
    SEAM(3);
    if (IN(4)) {
        pg8::Gemm g{(const bf16_t*)(ws + WS_A3), (const bf16_t*)(ws + WS_BT3), DM, 2048, 1024  , 0}; pg8::StaticOrder so; so.init(S, DM, G, bid);
        pg8::Epi3 E{(bf16_t*)(ws + WS_MRG), (const bf16_t*)(ws + WS_G)};
        pg8::gemm_phase(lds, g, so, E);
        if (REP_MASK & 16) { __syncthreads(); pg8::gemm_phase(lds, g, so, E); }
    }
    SEAM(4);
    if (IN(5)) {
        pg8::Gemm g{(const bf16_t*)(ws + WS_MRG), (const bf16_t*)(ws + WS_BT4), DM, DM, DM, 0}; pg8::StaticOrder so; so.init(S, DM, G, bid);
        pg8::EpiResLn<false> E{P.x, nullptr, nullptr, (bf16_t*)(ws + WS_X1B), P.ln1g, P.ln1b, (float*)(ws + WS_ST1), (unsigned*)(ws + 16384)};
        pg8::gemm_phase(lds, g, so, E);
    }
    SEAM(5);
    if (IN(7)) {
        pg8::Gemm g{(const bf16_t*)(ws + WS_X1B), (const bf16_t*)(ws + WS_BT5), DM, DM, DM, 0}; pg8::StaticOrder so; so.init(S, FF, G, bid);
        pg8::EpiBf16<1> E{(bf16_t*)(ws + WS_ACT), FFP, 0, nullptr};
        pg8::gemm_phase(lds, g, so, E);
        if (REP_MASK & 128) { __syncthreads(); pg8::gemm_phase(lds, g, so, E); }
    }
    SEAM(7);
    if (IN(8)) {
        pg8::Gemm g{(const bf16_t*)(ws + WS_ACT), (const bf16_t*)(ws + WS_BT6), FFP, FFP, FF, 0}; pg8::StaticOrder so; so.init(S, DM, G, bid);

        pg8::EpiResLn<true> E{nullptr, (const bf16_t*)(ws + WS_X1B), P.out, nullptr, P.ln2g, P.ln2b, (float*)(ws + WS_ST2), (unsigned*)(ws + 24576)};
        pg8::gemm_phase(lds, g, so, E);
    }
#undef IN
#undef SEAM
}

#ifdef DBG_STOP
__global__ void dbg_dump(const bf16_t* src, float* out, int n) { for (int i = blockIdx.x * blockDim.x + threadIdx.x; i < n; i += gridDim.x * blockDim.x) out[i] = __builtin_bit_cast(float, (unsigned)src[i] << 16); }
#endif
extern "C" void kernel_launch(void* const* d_in, const int* in_sizes, int n_in, void* d_out, int out_size, void* d_ws, size_t ws_size, hipStream_t stream) {
    static int grid = 0;
    if (grid == 0) {
        if (n_in != 14 || out_size != S * DM || ws_size < WS_END) { fprintf(stderr, "kernel_launch: unexpected problem (n_in %d, out %d, ws %zu < %zu)\n", n_in, out_size, ws_size, (size_t)WS_END); grid = -1; return; }
        if (hipFuncSetAttribute((const void*)mega_fwd, hipFuncAttributeMaxDynamicSharedMemorySize, LDS_BYTES) != hipSuccess) { fprintf(stderr, "kernel_launch: hipFuncSetAttribute failed\n"); grid = -1; return; }
        int dev = 0, cus = 0, per_cu = 0;
        hipGetDevice(&dev); hipDeviceGetAttribute(&cus, hipDeviceAttributeMultiprocessorCount, dev);
        hipOccupancyMaxActiveBlocksPerMultiprocessor(&per_cu, (const void*)mega_fwd, 512, LDS_BYTES);
        if (per_cu < 1) { fprintf(stderr, "kernel_launch: occupancy query says %d blocks per CU\n", per_cu); per_cu = 1; }
        (void)hipGetLastError();
        grid = cus;
    }
    if (grid < 0) return;
    Args a{};
    for (int i = 0; i < 14; ++i) a.in[i] = d_in[i];
    a.out = (float*)d_out; a.ws = (unsigned char*)d_ws;
#if N_LAUNCH_MODE == 0
    if (hipMemsetAsync(d_ws, 0, WS_ZERO_BYTES, stream) != hipSuccess) { fprintf(stderr, "kernel_launch: memset of the barrier words failed\n"); return; }
    a.ph_lo = 0; a.ph_hi = NPH;
    void* args[] = {&a};
    hipError_t e = hipLaunchCooperativeKernel((const void*)mega_fwd, dim3(grid), dim3(512), args, LDS_BYTES, stream);
    if (e != hipSuccess) fprintf(stderr, "cooperative launch failed: %s (grid %d)\n", hipGetErrorString(e), grid);
#else
#ifdef DBG_STOP
    for (int ph = 0; ph <= DBG_STOP; ++ph) { a.ph_lo = ph; a.ph_hi = ph + 1; hipLaunchKernelGGL(mega_fwd, dim3(grid), dim3(512), LDS_BYTES, stream, a); }
    hipLaunchKernelGGL(dbg_dump, dim3(2048), dim3(256), 0, stream, (const bf16_t*)((unsigned char*)d_ws + (size_t)DBG_OFF * MiB), (float*)d_out, S * DM);
#else
    for (int ph = 0; ph < NPH; ++ph) { a.ph_lo = ph; a.ph_hi = ph + 1; hipLaunchKernelGGL(mega_fwd, dim3(grid), dim3(512), LDS_BYTES, stream, a); }
#endif
#endif
}
```

```cpp
#include <hip/hip_runtime.h>
#include <hip/hip_cooperative_groups.h>
#include <cstdio>
#include <cstdint>
namespace cg = cooperative_groups;

#ifndef N_LAUNCH_MODE
#define N_LAUNCH_MODE 0
#endif

#define LAS __attribute__((address_space(3)))
typedef unsigned short bf16_t;
typedef short bf16x8 __attribute__((ext_vector_type(8)));
typedef short s16x4 __attribute__((ext_vector_type(4)));
typedef float f32x4 __attribute__((ext_vector_type(4)));
typedef unsigned u32x4 __attribute__((ext_vector_type(4)));
typedef unsigned u32x2 __attribute__((ext_vector_type(2)));

constexpr int S = 8192, DM = 2048, IW = 8192, AW = 1024, FF = 8192, NH = 8;
constexpr float LN_EPS = 1e-5f;
constexpr float ALPHA = 1.189207115002721f;
constexpr float QSCALE = 0.08838834764831845f * 1.4426950408889634f;
constexpr int NPH = 10;

constexpr size_t MiB = 1u << 20;
constexpr size_t WS_ST1 = 65536, WS_ST2 = 82 * MiB + 524288  , WS_ZERO_BYTES = 32768;
static_assert(WS_ST1 + 524288 <= (1u << 20), "control MiB");
constexpr int FFP = FF + 64;
constexpr size_t WS_BT5 = 1 * MiB, WS_BT6 = 33 * MiB, WS_BT3 = 66 * MiB, WS_BT4 = 74 * MiB, WS_WPT = 82 * MiB, WS_COS = 83 * MiB, WS_SIN = 85 * MiB, WS_LSE = 87 * MiB;
constexpr size_t WS_X = 88 * MiB;
constexpr size_t WS_BT1 = WS_X, WS_XB = WS_X + 32 * MiB, WS_OP = WS_X, WS_P = WS_X + 48 * MiB, WS_MRG = WS_X, WS_X1B = WS_X;
constexpr size_t WS_H1 = 152 * MiB, WS_A3 = WS_H1, WS_G = 216 * MiB, WS_ACT = 152 * MiB, WS_END = 281 * MiB;
static_assert(WS_BT6 + (size_t)DM * FFP * 2 <= WS_BT3 && WS_ACT + (size_t)S * FFP * 2 <= WS_END, "workspace map");

constexpr int OST_OFF = 131072 + 1024;
constexpr int LDS_BYTES = OST_OFF + 8 * 2304;

typedef float f32x2_t __attribute__((ext_vector_type(2))); typedef __bf16 bf16x2_t __attribute__((ext_vector_type(2)));
__device__ __forceinline__ unsigned cvt_pk_bf16(float lo, float hi) { f32x2_t v = {lo, hi}; bf16x2_t b = __builtin_convertvector(v, bf16x2_t); return __builtin_bit_cast(unsigned, b); }
__device__ __forceinline__ float bf_lo(unsigned w) { return __builtin_bit_cast(float, w << 16); }
__device__ __forceinline__ float bf_hi(unsigned w) { return __builtin_bit_cast(float, w & 0xffff0000u); }
#define LDS_WAIT() asm volatile("s_waitcnt lgkmcnt(0)" ::: "memory")

#define XB_TMO      128
#define XB_XCNT(j)  (256  + 64 * (j))
#define XB_XSUB(j)  (1280 + 64 * (j))
#define XB_XGEN(j)  (2304 + 64 * (j))
#define XB_TOP      3328
#define XB_TOPGEN   3392
#define XCD_BAR_WORDS 3456
#define XB_SPIN_CAP (1u << 22)
__device__ __forceinline__ unsigned xb_ld(unsigned* p)              { return __hip_atomic_load(p, __ATOMIC_RELAXED, __HIP_MEMORY_SCOPE_AGENT); }
__device__ __forceinline__ unsigned xb_add(unsigned* p, unsigned v) { return __hip_atomic_fetch_add(p, v, __ATOMIC_RELAXED, __HIP_MEMORY_SCOPE_AGENT); }
__device__ __forceinline__ unsigned xb_xcc_id() { return (unsigned)__builtin_amdgcn_s_getreg((3 << 11) | 20) & 0xFu; }
#define XB_SPIN(cond, bar) do { unsigned _sp = 0; while (cond) { __builtin_amdgcn_s_sleep(1); \
    if ((++_sp & 255u) == 0u) { if (xb_ld(&(bar)[XB_TMO])) break; if (_sp > XB_SPIN_CAP) { atomicAdd(&(bar)[XB_TMO], 1u); break; } } } } while (0)
struct XcdBarrier { unsigned* bar; unsigned x; volatile LAS unsigned* st; };
__device__ __forceinline__ XcdBarrier xcd_barrier_post(unsigned* bar, volatile LAS unsigned* st) {
    XcdBarrier b; b.bar = bar; b.x = xb_xcc_id(); b.st = st;
    if (threadIdx.x == 0) (void)xb_add(&bar[XB_XCNT(b.x)], 1u);
    return b;
}
__device__ __forceinline__ void xcd_barrier_complete(unsigned* bar, unsigned x, unsigned& nloc, unsigned& nx) {
    const unsigned G = gridDim.x * gridDim.y * gridDim.z;
    unsigned sum, cnt, mine, sp = 0u;
    for (;;) {
        sum = 0u; cnt = 0u; mine = 0u;
#pragma unroll
        for (unsigned j = 0; j < 16; ++j) { const unsigned c = xb_ld(&bar[XB_XCNT(j)]); sum += c; cnt += (c > 0u) ? 1u : 0u; mine = (j == x) ? c : mine; }
        if (sum == G) break;
        __builtin_amdgcn_s_sleep(1);
        if ((++sp & 255u) == 0u) { if (xb_ld(&bar[XB_TMO])) break; if (sp > XB_SPIN_CAP) { atomicAdd(&bar[XB_TMO], 1u); break; } }
    }
    nloc = mine > 0u ? mine : 1u; nx = cnt > 0u ? cnt : 1u;
}
__device__ __forceinline__ void xcd_barrier(const XcdBarrier& b) {
    asm volatile("s_waitcnt vmcnt(0)" ::: "memory");
    __syncthreads();
    if (threadIdx.x == 0) {
        unsigned* bar = b.bar;
        __builtin_amdgcn_s_waitcnt(0);
        unsigned nloc = b.st[0], nx = b.st[1];
        if (nloc == 0u) { xcd_barrier_complete(bar, b.x, nloc, nx); b.st[0] = nloc; b.st[1] = nx; }
        const unsigned old = xb_add(&bar[XB_XSUB(b.x)], 1u);
        const unsigned gen = old / nloc;
        if (old + 1u == (gen + 1u) * nloc) {
            __builtin_amdgcn_fence(__ATOMIC_RELEASE, "agent");
            asm volatile("s_waitcnt vmcnt(0)" ::: "memory");
            const unsigned og = xb_add(&bar[XB_TOP], 1u);
            const unsigned tg = og / nx;
            if (og + 1u == (tg + 1u) * nx) xb_add(&bar[XB_TOPGEN], 1u);
            else XB_SPIN(xb_ld(&bar[XB_TOPGEN]) == tg, bar);
            __builtin_amdgcn_fence(__ATOMIC_ACQUIRE, "agent");
            xb_add(&bar[XB_XGEN(b.x)], 1u);
            asm volatile("s_waitcnt vmcnt(0)" ::: "memory");
        } else {
            XB_SPIN(xb_ld(&bar[XB_XGEN(b.x)]) == gen, bar);
            __builtin_amdgcn_fence(__ATOMIC_ACQUIRE, "agent");
            asm volatile("s_waitcnt vmcnt(0)" ::: "memory");
        }
    }
    __syncthreads();
}

namespace pg8 {
constexpr int BM = 256, BK = 64, HALF = 128, HTB = HALF * BK * 2, NXCD = 8, WGM = 4;
__host__ __device__ __forceinline__ int lds_byte(int r, int c) { const int st = (r >> 4) * 2 + (c >> 5), rr = r & 15, cc = c & 31, ob = rr * 64 + cc * 2; return st * 1024 + (ob ^ (((ob >> 9) & 1) << 5)); }
__host__ __device__ __forceinline__ void stage_rc(int b, int& R, int& C) { const int st = b / 1024, sb = b % 1024, swz = sb ^ (((sb >> 9) & 1) << 5); R = (st >> 1) * 16 + swz / 64; C = (st & 1) * 32 + (swz % 64) / 2; }
__host__ __device__ __forceinline__ int perm32(int rho) { const int n = rho >> 4, i = rho & 15; return 8 * (i >> 2) + 4 * n + (i & 3); }

struct Unit { int pm, pn; };
struct Gemm { const bf16_t* A; const bf16_t* Bt; int lda, ldb, K, apn; };

struct StaticOrder {
    int nM, nN, nwg, G, c, mix;
    __device__ void init(int M, int N, int G_, int c_, int mix_ = 0) { nM = M / BM; nN = N / BM; nwg = nM * nN; G = G_; c = c_; mix = mix_; }
    __device__ bool next(int i, Unit& u) const {
        const long L = (long)i * G + c; if (L >= nwg) return false;
        int wgid = (int)L; { const int q = nwg / NXCD, r = nwg % NXCD, xcd = wgid % NXCD, off = wgid / NXCD; wgid = (xcd < r ? xcd * (q + 1) : r * (q + 1) + (xcd - r) * q) + off; }
        const int nig = WGM * nN, gid = wgid / nig, fm = gid * WGM, gsz = (nM - fm) < WGM ? (nM - fm) : WGM;
        u.pm = fm + ((wgid % nig) % gsz); u.pn = (wgid % nig) / gsz;
        if (mix) { const int j = u.pn; u.pn = 16 * ((j >> 3) & 1) + 8 * ((j >> 4) & 1) + (j & 7); }
        return true;
    }
};

typedef f32x4 Acc[2][2][4][2];

template <class Epi>
__device__ __forceinline__ void gemm_phase(LAS unsigned char* lds, const Gemm g, const StaticOrder& S, const Epi& E) {
    const int tid = threadIdx.x, wid = __builtin_amdgcn_readfirstlane(tid >> 6), lane = tid & 63, wr = wid >> 2, wc = wid & 3, fr = lane & 15, fq = lane >> 4;
    const int K = g.K, nt = K / BK;
    unsigned voffA[2], voffB[2];
#pragma unroll
    for (int i = 0; i < 2; ++i) { int R, C; stage_rc(tid * 16 + i * 8192, R, C); const int Rb = Epi::PERM ? ((R & ~31) + perm32(R & 31)) : R;
        voffA[i] = (unsigned)(R * g.lda + C) * 2u; voffB[i] = (unsigned)(Rb * g.ldb + C) * 2u; }
    const size_t kstep = (size_t)(BK * 2);
    const size_t hstepA = (size_t)HALF * g.lda * 2, hstepB = (size_t)HALF * g.ldb * 2;
    const size_t tstepA = 2 * hstepA, tstepB = 2 * hstepB;
    const unsigned ldsw = (unsigned)wid * 1024u;
    const int aoff = lds_byte(wr * 64 + fr, fq * 8), boff = lds_byte(wc * 32 + fr, fq * 8);
#define PG8_SA(b, h) (((b) * 2 + (h)) * HTB)
#define PG8_SB(b, h) ((4 + (b) * 2 + (h)) * HTB)
#define PG8_STAGE(bufoff, gbase, voff) do { _Pragma("unroll") for (int _i = 0; _i < 2; ++_i) \
        __builtin_amdgcn_global_load_lds((const unsigned*)((const char*)(gbase) + (voff)[_i]), (LAS unsigned*)(lds + (bufoff) + ldsw + _i * 8192), 16, 0, 0); } while (0)
#define PG8_LDA(dst, b, h) do { _Pragma("unroll") for (int m = 0; m < 4; ++m) _Pragma("unroll") for (int k = 0; k < 2; ++k) dst[m][k] = *(const LAS bf16x8*)(lds + PG8_SA(b, h) + aoff + m * 2048 + k * 1024); } while (0)
#define PG8_LDB(dst, b, h) do { _Pragma("unroll") for (int n = 0; n < 2; ++n) _Pragma("unroll") for (int k = 0; k < 2; ++k) dst[n][k] = *(const LAS bf16x8*)(lds + PG8_SB(b, h) + boff + n * 2048 + k * 1024); } while (0)
#define PG8_MMA(ai, bj, At, Bt) do { __builtin_amdgcn_s_setprio(1); _Pragma("unroll") for (int m = 0; m < 4; ++m) _Pragma("unroll") for (int n = 0; n < 2; ++n) _Pragma("unroll") for (int k = 0; k < 2; ++k) \
        acc[ai][bj][m][n] = __builtin_amdgcn_mfma_f32_16x16x32_bf16(Bt[n][k], At[m][k], acc[ai][bj][m][n], 0, 0, 0); __builtin_amdgcn_s_setprio(0); } while (0)
#define PG8_WAIT_V(n) asm volatile("s_waitcnt vmcnt(" #n ")" ::: "memory")
#define PG8_WAIT_L(n) asm volatile("s_waitcnt lgkmcnt(" #n ")" ::: "memory")
#define PG8_BAR __builtin_amdgcn_s_barrier()
#define PG8_SCHED __builtin_amdgcn_sched_barrier(0)
    Unit cur, nxt; int ui = 0;
#define PG8_NEXT(i, u) (Epi::MID ? S.next((i) >> 1, u) : S.next((i), u))
#define PG8_KOFF(i) (Epi::MID ? (size_t)((i) & 1) * (size_t)K * 2 : (size_t)0)
    if (!PG8_NEXT(0, cur)) return;
    Acc acc;
#pragma unroll
    for (int a = 0; a < 2; ++a)
#pragma unroll
        for (int b = 0; b < 2; ++b)
#pragma unroll
            for (int m = 0; m < 4; ++m)
#pragma unroll
                for (int n = 0; n < 2; ++n) acc[a][b][m][n] = (f32x4){0.f, 0.f, 0.f, 0.f};
    bf16x8 At[4][2], B0[2][2], B1[2][2];
    const char* cA = (const char*)g.A + (size_t)cur.pm * tstepA + (size_t)cur.pn * g.apn + PG8_KOFF(0); const char* cB = (const char*)g.Bt + (size_t)cur.pn * tstepB + PG8_KOFF(0);
    PG8_STAGE(PG8_SB(0, 0), cB, voffB); PG8_STAGE(PG8_SB(0, 1), cB + hstepB, voffB); PG8_STAGE(PG8_SA(0, 0), cA, voffA); PG8_STAGE(PG8_SA(0, 1), cA + hstepA, voffA);
    if (wr == 1) PG8_BAR;
    PG8_WAIT_V(2); PG8_BAR;
    PG8_STAGE(PG8_SB(1, 0), cB + kstep, voffB); PG8_STAGE(PG8_SA(1, 0), cA + kstep, voffA); PG8_STAGE(PG8_SB(1, 1), cB + hstepB + kstep, voffB);
    PG8_WAIT_V(6); PG8_BAR;
    for (;;) {
        const bool has_next = PG8_NEXT(ui + 1, nxt);
        const char* nA = has_next ? (const char*)g.A + (size_t)nxt.pm * tstepA + (size_t)nxt.pn * g.apn + PG8_KOFF(ui + 1) : cA; const char* nB = has_next ? (const char*)g.Bt + (size_t)nxt.pn * tstepB + PG8_KOFF(ui + 1) : cB;
#pragma nounroll
        for (int t = 0; t < nt; t += 2) {
            const bool last = (t == nt - 2);
            const char* a1 = cA + (size_t)(t + 1) * kstep;
            const char* a2 = last ? nA : cA + (size_t)(t + 2) * kstep; const char* b2 = last ? nB : cB + (size_t)(t + 2) * kstep;
            const char* a3 = a2 + kstep; const char* b3 = b2 + kstep;
            PG8_LDB(B0, 0, 0); PG8_LDB(B1, 0, 1); PG8_SCHED; PG8_LDA(At, 0, 0); PG8_STAGE(PG8_SA(1, 1), a1 + hstepA, voffA);
            PG8_WAIT_V(8); PG8_WAIT_L(0); PG8_BAR; PG8_MMA(0, 0, At, B0); PG8_MMA(0, 1, At, B1); PG8_BAR; PG8_SCHED;
            PG8_LDA(At, 0, 1); PG8_STAGE(PG8_SB(0, 0), b2, voffB); PG8_STAGE(PG8_SB(0, 1), b2 + hstepB, voffB); PG8_STAGE(PG8_SA(0, 0), a2, voffA);
            PG8_WAIT_V(8); PG8_WAIT_L(0); PG8_BAR; PG8_MMA(1, 0, At, B0); PG8_MMA(1, 1, At, B1); PG8_BAR; PG8_SCHED;
            PG8_LDB(B0, 1, 0); PG8_LDB(B1, 1, 1); PG8_SCHED; PG8_LDA(At, 1, 0); PG8_STAGE(PG8_SA(0, 1), a2 + hstepA, voffA);
            PG8_WAIT_V(8); PG8_WAIT_L(0); PG8_BAR; PG8_MMA(0, 0, At, B0); PG8_MMA(0, 1, At, B1); PG8_BAR; PG8_SCHED;
            PG8_LDA(At, 1, 1); PG8_STAGE(PG8_SB(1, 0), b3, voffB); PG8_STAGE(PG8_SB(1, 1), b3 + hstepB, voffB); PG8_STAGE(PG8_SA(1, 0), a3, voffA);
            PG8_WAIT_V(8); PG8_WAIT_L(0); PG8_BAR; PG8_MMA(1, 0, At, B0); PG8_MMA(1, 1, At, B1); PG8_BAR; PG8_SCHED;
        }
        if (wr == 0) PG8_BAR;
        bool fin = true;
        if constexpr (Epi::MID) { if ((ui & 1) == 0) { E.mid(acc, cur, wr, wc, fr, fq); fin = false; } }
        if constexpr (!Epi::FUSED) { if (fin) E(acc, cur, wr, wc, fr, fq); }
        if (!has_next) break;
        if (fin) {
#pragma unroll
        for (int a = 0; a < 2; ++a)
#pragma unroll
            for (int b = 0; b < 2; ++b)
#pragma unroll
                for (int m = 0; m < 4; ++m)
#pragma unroll
                    for (int n = 0; n < 2; ++n) acc[a][b][m][n] = (f32x4){0.f, 0.f, 0.f, 0.f};
        }
        cur = nxt; cA = nA; cB = nB; ++ui;
        if (wr == 1) PG8_BAR;
    }
    PG8_WAIT_V(0);
    PG8_BAR;
    if constexpr (Epi::FUSED) E.fused(acc, cur, wr, wc, fr, fq, lds);
#undef PG8_NEXT
#undef PG8_KOFF
#undef PG8_SA
#undef PG8_SB
#undef PG8_STAGE
#undef PG8_LDA
#undef PG8_LDB
#undef PG8_MMA
#undef PG8_WAIT_V
#undef PG8_WAIT_L
#undef PG8_BAR
#undef PG8_SCHED
}

struct Epi1 {
    static constexpr bool PERM = true, MID = false, FUSED = false;
    bf16_t* H1; bf16_t* G; const float* cosT; const float* sinT;
    __device__ __forceinline__ void operator()(const Acc& acc, const Unit& u, int wr, int wc, int fr, int fq) const {
        const int row0 = u.pm * BM + wr * 64 + fr;
        if (u.pn < 8) {
            const float sc = (u.pn < 4) ? QSCALE : 1.0f;
            const int d0 = 16 * wc + 4 * fq;
#pragma unroll
            for (int ai = 0; ai < 2; ++ai)
#pragma unroll
                for (int m = 0; m < 4; ++m) { const int row = row0 + ai * HALF + m * 16;
                    const f32x4 cs = *(const f32x4*)(cosT + (size_t)row * 64 + d0) * sc, sn = *(const f32x4*)(sinT + (size_t)row * 64 + d0) * sc;
#pragma unroll
                    for (int bj = 0; bj < 2; ++bj) { const f32x4 v0 = acc[ai][bj][m][0], v1 = acc[ai][bj][m][1];
                        const f32x4 lo = v0 * cs - v1 * sn, hi = v1 * cs + v0 * sn;
                        bf16_t* p = H1 + (size_t)row * 4096 + u.pn * BM + bj * HALF + d0;
                        u32x2 a, b; a.x = cvt_pk_bf16(lo[0], lo[1]); a.y = cvt_pk_bf16(lo[2], lo[3]); b.x = cvt_pk_bf16(hi[0], hi[1]); b.y = cvt_pk_bf16(hi[2], hi[3]);
                        *(u32x2*)p = a; *(u32x2*)(p + 64) = b; } }
        } else if (u.pn < 16) {
            const int col0 = u.pn * BM + wc * 32 + 8 * fq;
#pragma unroll
            for (int ai = 0; ai < 2; ++ai)
#pragma unroll
                for (int m = 0; m < 4; ++m) { bf16_t* rowp = H1 + (size_t)(row0 + ai * HALF + m * 16) * 4096 + col0;
#pragma unroll
                    for (int bj = 0; bj < 2; ++bj) { const f32x4 v0 = acc[ai][bj][m][0], v1 = acc[ai][bj][m][1];
                        u32x4 w; w.x = cvt_pk_bf16(v0[0], v0[1]); w.y = cvt_pk_bf16(v0[2], v0[3]); w.z = cvt_pk_bf16(v1[0], v1[1]); w.w = cvt_pk_bf16(v1[2], v1[3]);
                        *(u32x4*)(rowp + bj * HALF) = w; } }
        } else {
            const int col0 = (u.pn - 16) * BM + wc * 32 + 8 * fq;
#pragma unroll
            for (int ai = 0; ai < 2; ++ai)
#pragma unroll
                for (int m = 0; m < 4; ++m) { bf16_t* rowp = G + (size_t)(row0 + ai * HALF + m * 16) * 4096 + col0;
#pragma unroll
                    for (int bj = 0; bj < 2; ++bj) { f32x4 v0 = acc[ai][bj][m][0], v1 = acc[ai][bj][m][1];
#pragma unroll
                        for (int j = 0; j < 4; ++j) { v0[j] = __builtin_amdgcn_rcpf(1.0f + __expf(-fmaxf(v0[j], -60.f))); v1[j] = __builtin_amdgcn_rcpf(1.0f + __expf(-fmaxf(v1[j], -60.f))); }
                        u32x4 w; w.x = cvt_pk_bf16(v0[0], v0[1]); w.y = cvt_pk_bf16(v0[2], v0[3]); w.z = cvt_pk_bf16(v1[0], v1[1]); w.w = cvt_pk_bf16(v1[2], v1[3]);
                        __builtin_nontemporal_store(w, (u32x4*)(rowp + bj * HALF)); } }
        }
    }
};
template <int ACT> struct EpiBf16 {
    static constexpr bool PERM = true, MID = false, FUSED = false;
    bf16_t* O; int ldc; int coloff; const float* scale;
    __device__ __forceinline__ void operator()(const Acc& acc, const Unit& u, int wr, int wc, int fr, int fq) const {
        const int row0 = u.pm * BM + wr * 64 + fr, col0 = u.pn * BM + wc * 32 + 8 * fq;
#pragma unroll
        for (int ai = 0; ai < 2; ++ai)
#pragma unroll
            for (int m = 0; m < 4; ++m) { bf16_t* rowp = O + (size_t)(row0 + ai * HALF + m * 16) * ldc + coloff + col0;
#pragma unroll
                for (int bj = 0; bj < 2; ++bj) { f32x4 v0 = acc[ai][bj][m][0], v1 = acc[ai][bj][m][1];
                    if (ACT == 1) {
#pragma unroll
                        for (int j = 0; j < 4; ++j) { const float a = fmaxf(v0[j], 0.f), b = fmaxf(v1[j], 0.f); v0[j] = a * a; v1[j] = b * b; } }
                    if (ACT == 2) { v0 = v0 * *(const f32x4*)(scale + col0 + bj * HALF); v1 = v1 * *(const f32x4*)(scale + col0 + bj * HALF + 4); }
                    u32x4 w; w.x = cvt_pk_bf16(v0[0], v0[1]); w.y = cvt_pk_bf16(v0[2], v0[3]); w.z = cvt_pk_bf16(v1[0], v1[1]); w.w = cvt_pk_bf16(v1[2], v1[3]);
                    *(u32x4*)(rowp + bj * HALF) = w; }
                if (ACT == 2) asm volatile("" ::: "memory"); }
    }
};
struct Epi3 {
    static constexpr bool PERM = true, MID = true, FUSED = false;
    bf16_t* O; const bf16_t* G;
    __device__ __forceinline__ void mid(Acc& acc, const Unit& u, int wr, int wc, int fr, int fq) const {
        const int row0 = u.pm * BM + wr * 64 + fr, col0 = u.pn * BM + wc * 32 + 8 * fq;
#pragma unroll
        for (int ai = 0; ai < 2; ++ai)
#pragma unroll
            for (int m = 0; m < 4; ++m) { const bf16_t* gp = G + (size_t)(row0 + ai * HALF + m * 16) * 4096 + col0;
#pragma unroll
                for (int bj = 0; bj < 2; ++bj) { const u32x4 a = __builtin_nontemporal_load((const u32x4*)(gp + bj * HALF)), b = *(const u32x4*)(gp + 2048 + bj * HALF);
                    f32x4 r0, r1;
                    r0[0] = bf_lo(a.x) * __builtin_amdgcn_rcpf(bf_lo(b.x)); r0[1] = bf_hi(a.x) * __builtin_amdgcn_rcpf(bf_hi(b.x)); r0[2] = bf_lo(a.y) * __builtin_amdgcn_rcpf(bf_lo(b.y)); r0[3] = bf_hi(a.y) * __builtin_amdgcn_rcpf(bf_hi(b.y));
                    r1[0] = bf_lo(a.z) * __builtin_amdgcn_rcpf(bf_lo(b.z)); r1[1] = bf_hi(a.z) * __builtin_amdgcn_rcpf(bf_hi(b.z)); r1[2] = bf_lo(a.w) * __builtin_amdgcn_rcpf(bf_lo(b.w)); r1[3] = bf_hi(a.w) * __builtin_amdgcn_rcpf(bf_hi(b.w));
                    acc[ai][bj][m][0] = acc[ai][bj][m][0] * r0; acc[ai][bj][m][1] = acc[ai][bj][m][1] * r1; }
                asm volatile("" ::: "memory"); }
    }
    __device__ __forceinline__ void operator()(const Acc& acc, const Unit& u, int wr, int wc, int fr, int fq) const {
        const int row0 = u.pm * BM + wr * 64 + fr, col0 = u.pn * BM + wc * 32 + 8 * fq;
#pragma unroll
        for (int ai = 0; ai < 2; ++ai)
#pragma unroll
            for (int m = 0; m < 4; ++m) { const size_t row = (size_t)(row0 + ai * HALF + m * 16); const bf16_t* gp = G + row * 4096 + 2048 + col0; bf16_t* rowp = O + row * DM + col0;
#pragma unroll
                for (int bj = 0; bj < 2; ++bj) { const u32x4 b = __builtin_nontemporal_load((const u32x4*)(gp + bj * HALF)); const f32x4 v0 = acc[ai][bj][m][0], v1 = acc[ai][bj][m][1];
                    u32x4 w; w.x = cvt_pk_bf16(v0[0] * bf_lo(b.x), v0[1] * bf_hi(b.x)); w.y = cvt_pk_bf16(v0[2] * bf_lo(b.y), v0[3] * bf_hi(b.y));
                    w.z = cvt_pk_bf16(v1[0] * bf_lo(b.z), v1[1] * bf_hi(b.z)); w.w = cvt_pk_bf16(v1[2] * bf_lo(b.w), v1[3] * bf_hi(b.w));
                    *(u32x4*)(rowp + bj * HALF) = w; }
                asm volatile("" ::: "memory"); }
    }
};
struct EpiRes {
    static constexpr bool PERM = false, MID = false, FUSED = false;
    const float* base; float* out;
    __device__ __forceinline__ void operator()(const Acc& acc, const Unit& u, int wr, int wc, int fr, int fq) const {
        const int row0 = u.pm * BM + wr * 64 + fr, col0 = u.pn * BM + wc * 32 + 4 * fq;
#pragma unroll
        for (int ai = 0; ai < 2; ++ai)
#pragma unroll
            for (int m = 0; m < 4; ++m) { const size_t off = (size_t)(row0 + ai * HALF + m * 16) * DM + col0;
#pragma unroll
                for (int bj = 0; bj < 2; ++bj)
#pragma unroll
                    for (int n = 0; n < 2; ++n) { const f32x4 bs = *(const f32x4*)(base + off + bj * HALF + n * 16); *(f32x4*)(out + off + bj * HALF + n * 16) = bs * ALPHA + acc[ai][bj][m][n]; } }
    }
};
template <bool BASE_BF16> struct EpiResLn {
    static constexpr bool PERM = false, MID = false, FUSED = true;
    const float* base; const bf16_t* baseb; float* out; bf16_t* xb; const float* gam; const float* bet; float* stats; unsigned* cnt;
    __device__ __forceinline__ void operator()(const Acc&, const Unit&, int, int, int, int) const {}
    __device__ __forceinline__ void fused(Acc& acc, const Unit& u, int wr, int wc, int fr, int fq, LAS unsigned char* lds) const {
        const int row0 = u.pm * BM + wr * 64 + fr, col0 = u.pn * BM + wc * 32 + 4 * fq;
        LAS float* Pst = (LAS float*)lds;
#pragma unroll
        for (int ai = 0; ai < 2; ++ai)
#pragma unroll
            for (int m = 0; m < 4; ++m) { const size_t off = (size_t)(row0 + ai * HALF + m * 16) * DM + col0; float s = 0.f, q = 0.f;
#pragma unroll
                for (int bj = 0; bj < 2; ++bj)
#pragma unroll
                    for (int n = 0; n < 2; ++n) { f32x4 bs; if (BASE_BF16) { const u32x2 wb = *(const u32x2*)(baseb + off + bj * HALF + n * 16); bs = (f32x4){bf_lo(wb.x), bf_hi(wb.x), bf_lo(wb.y), bf_hi(wb.y)}; } else bs = __builtin_nontemporal_load((const f32x4*)(base + off + bj * HALF + n * 16));
                        const f32x4 v = bs * ALPHA + acc[ai][bj][m][n]; acc[ai][bj][m][n] = v;
                        s += (v[0] + v[1]) + (v[2] + v[3]); q += (v[0] * v[0] + v[1] * v[1]) + (v[2] * v[2] + v[3] * v[3]); }
                s += __shfl_xor(s, 16); s += __shfl_xor(s, 32); q += __shfl_xor(q, 16); q += __shfl_xor(q, 32);
                if (fq == 0) { const int rl = ai * HALF + wr * 64 + m * 16 + fr; Pst[(rl * 4 + wc) * 2] = s; Pst[(rl * 4 + wc) * 2 + 1] = q; }
                asm volatile("" ::: "memory"); }
        __syncthreads();
        if (threadIdx.x < 256) { const int rl = threadIdx.x; float s = 0.f, q = 0.f;
#pragma unroll
            for (int w = 0; w < 4; ++w) { s += Pst[(rl * 4 + w) * 2]; q += Pst[(rl * 4 + w) * 2 + 1]; }
            unsigned long long* st = (unsigned long long*)stats + ((size_t)(u.pm * BM + rl) * 8 + u.pn);
            __hip_atomic_store(st, ((unsigned long long)__float_as_uint(q) << 32) | __float_as_uint(s), __ATOMIC_RELAXED, __HIP_MEMORY_SCOPE_AGENT); }
        asm volatile("s_waitcnt vmcnt(0)" ::: "memory");
        __syncthreads();
        if (threadIdx.x == 0) { unsigned* c = cnt + 64 * u.pm; (void)xb_add(c, 1u); unsigned sp = 0u;
            while (xb_ld(c) < 8u) { __builtin_amdgcn_s_sleep(1); if (++sp > XB_SPIN_CAP) break; } }
        __syncthreads();
        LAS float* Sst = (LAS float*)(lds + 8192);
        if (threadIdx.x < 256) { const int rl = threadIdx.x; const unsigned long long* st = (const unsigned long long*)stats + (size_t)(u.pm * BM + rl) * 8; float s = 0.f, q = 0.f;
#pragma unroll
            for (int t = 0; t < 8; ++t) { const unsigned long long v = __hip_atomic_load(st + t, __ATOMIC_RELAXED, __HIP_MEMORY_SCOPE_AGENT); s += __uint_as_float((unsigned)v); q += __uint_as_float((unsigned)(v >> 32)); }
            const float mean = s * (1.0f / DM); const float var = fmaxf(q * (1.0f / DM) - mean * mean, 0.f);
            Sst[rl * 2] = mean; Sst[rl * 2 + 1] = 1.0f / sqrtf(var + LN_EPS); }
        __syncthreads();
#pragma unroll
        for (int ai = 0; ai < 2; ++ai)
#pragma unroll
            for (int m = 0; m < 4; ++m) { const int row = row0 + ai * HALF + m * 16; const size_t off = (size_t)row * DM + col0;
                const int rl = ai * HALF + wr * 64 + m * 16 + fr; const float mean = Sst[rl * 2], rstd = Sst[rl * 2 + 1];
#pragma unroll
                for (int bj = 0; bj < 2; ++bj)
#pragma unroll
                    for (int n = 0; n < 2; ++n) { const int c = col0 + bj * HALF + n * 16; const f32x4 gg = *(const f32x4*)(gam + c), bb = *(const f32x4*)(bet + c);
                        const f32x4 y = (acc[ai][bj][m][n] - mean) * rstd * gg + bb; if (out) __builtin_nontemporal_store(y, (f32x4*)(out + off + bj * HALF + n * 16));
                        if (xb) { u32x2 wv; wv.x = cvt_pk_bf16(y[0], y[1]); wv.y = cvt_pk_bf16(y[2], y[3]); *(u32x2*)(xb + off + bj * HALF + n * 16) = wv; } }
                asm volatile("" ::: "memory"); }
    }
};
}

__device__ __forceinline__ int rope_permd(int d) { return 8 * ((d & 63) >> 2) + 4 * (d >> 6) + (d & 3); }
__device__ __forceinline__ void transpose_item(const float* W, int N, bf16_t* WT, int ldw, int coloff, int row_off, bool rope, LAS float* scr, int kb, int nb, int lane, const float* rscale = nullptr) {
    const int k0 = 64 * kb, n0 = 64 * nb;
    const int lk = lane >> 4, n4 = 4 * (lane & 15);
    f32x4 tv[16];
#pragma unroll
    for (int i = 0; i < 16; ++i) tv[i] = __builtin_nontemporal_load((const f32x4*)(W + (size_t)(k0 + 4 * i + lk) * N + n0 + n4));
#pragma unroll
    for (int i = 0; i < 16; ++i) { const int k = 4 * i + lk; *(LAS f32x4*)(scr + k * 64 + (n4 ^ (4 * (k >> 3)))) = tv[i]; }
    LDS_WAIT(); asm volatile("" ::: "memory");
    const int c = lane & 7;
#pragma unroll
    for (int j = 0; j < 8; ++j) { const int n = (lane >> 3) + 8 * j; const LAS float* s = scr + (8 * c) * 64 + (n ^ (4 * c));
        const float rs = rscale ? rscale[n0 + n] : 1.0f;
        u32x4 o; o.x = cvt_pk_bf16(s[0 * 64] * rs, s[1 * 64] * rs); o.y = cvt_pk_bf16(s[2 * 64] * rs, s[3 * 64] * rs); o.z = cvt_pk_bf16(s[4 * 64] * rs, s[5 * 64] * rs); o.w = cvt_pk_bf16(s[6 * 64] * rs, s[7 * 64] * rs);
        const int ncol = n0 + n; const int drow = (rope && ncol < 2048) ? ((ncol & ~127) + rope_permd(ncol & 127)) : ncol;
        *(u32x4*)(WT + (size_t)(row_off + drow) * ldw + coloff + k0 + 8 * c) = o; }
    LDS_WAIT(); asm volatile("" ::: "memory");
}

struct Ptrs {
    const float *x, *w_in, *w_pool, *pool_scale, *w_ba, *w_bb, *w_out, *ln1g, *ln1b, *w_ff1, *w_ff2, *ln2g, *ln2b; const int* pos;
    float* out; unsigned char* ws;
};

template <bool late> __device__ __forceinline__ void p0_prologue(const Ptrs& P, LAS unsigned char* lds, int G, int bid) {
    const int tid = threadIdx.x, lane = tid & 63, wave = __builtin_amdgcn_readfirstlane(tid >> 6);
    LAS float* scr = (LAS float*)(lds + wave * 16384);
    const int gw = bid * 8 + wave, NGW = G * 8;
    bf16_t* Bt1 = (bf16_t*)(P.ws + WS_BT1); bf16_t* Bt3 = (bf16_t*)(P.ws + WS_BT3); bf16_t* Bt4 = (bf16_t*)(P.ws + WS_BT4); bf16_t* Bt5 = (bf16_t*)(P.ws + WS_BT5); bf16_t* Bt6 = (bf16_t*)(P.ws + WS_BT6); bf16_t* WpT = (bf16_t*)(P.ws + WS_WPT);
    constexpr int I_IN = (DM / 64) * (IW / 64), I_PL = 4 * (256 / 64) * (256 / 64), I_BA = (AW / 64) * (DM / 64), I_OUT = (DM / 64) * (DM / 64), I_F1 = (DM / 64) * (FF / 64), I_F2 = (FF / 64) * (DM / 64);
    constexpr int NITEMS = late ? (2 * I_BA + I_OUT + I_F1 + I_F2) : (I_IN + I_PL);
    for (int it = gw; it < NITEMS; it += NGW) {
        int r = it;
        if (late) {
            if (r < I_BA) { transpose_item(P.w_ba, DM, Bt3, 2048, 0, 0, false, scr, r / (DM / 64), r % (DM / 64), lane); continue; } r -= I_BA;
            if (r < I_BA) { transpose_item(P.w_bb, DM, Bt3, 2048, 1024, 0, false, scr, r / (DM / 64), r % (DM / 64), lane); continue; } r -= I_BA;
            if (r < I_OUT) { transpose_item(P.w_out, DM, Bt4, DM, 0, 0, false, scr, r / (DM / 64), r % (DM / 64), lane); continue; } r -= I_OUT;
            if (r < I_F1) { transpose_item(P.w_ff1, FF, Bt5, DM, 0, 0, false, scr, r / (FF / 64), r % (FF / 64), lane); continue; } r -= I_F1;
            transpose_item(P.w_ff2, DM, Bt6, FFP, 0, 0, false, scr, r / (DM / 64), r % (DM / 64), lane); continue; }
        if (r < I_IN) { transpose_item(P.w_in, IW, Bt1, DM, 0, 0, true, scr, r / (IW / 64), r % (IW / 64), lane); continue; } r -= I_IN;
        { const int g = r / 16, q = r % 16; transpose_item(P.w_pool + (size_t)g * 65536, 256, WpT, 256, 0, g * 256, false, scr, q / 4, q % 4, lane, P.pool_scale + g * 256); }
    }
    if (late) return;
    const int gt = bid * 512 + tid, NGT = G * 512;
    bf16_t* xb = (bf16_t*)(P.ws + WS_XB);
    for (int i = gt; i < S * DM / 8; i += NGT) { const f32x4 a = __builtin_nontemporal_load((const f32x4*)(P.x + (size_t)i * 8)), b = __builtin_nontemporal_load((const f32x4*)(P.x + (size_t)i * 8 + 4));
        u32x4 w; w.x = cvt_pk_bf16(a[0], a[1]); w.y = cvt_pk_bf16(a[2], a[3]); w.z = cvt_pk_bf16(b[0], b[1]); w.w = cvt_pk_bf16(b[2], b[3]); *(u32x4*)(xb + (size_t)i * 8) = w; }
    float* cosT = (float*)(P.ws + WS_COS); float* sinT = (float*)(P.ws + WS_SIN);
    const double invf_rev = exp(-(double)(gt & 63) * (9.210340371976184 / 64.0)) * 0.15915494309189535;
    for (int i = gt; i < S * 64; i += NGT) { const int t = i >> 6, f = i & 63;
        const double invf = (NGT & 63) ? exp(-(double)f * (9.210340371976184 / 64.0)) * 0.15915494309189535 : invf_rev; const double rev = (double)P.pos[t] * invf; const float fr = (float)(rev - floor(rev));
        cosT[i] = __builtin_amdgcn_cosf(fr); sinT[i] = __builtin_amdgcn_sinf(fr); }
}

__device__ __forceinline__ unsigned off_k(unsigned row, unsigned ch) { return 256u * row + 16u * (ch ^ (row & 15u)); }
__device__ __forceinline__ unsigned off_v(unsigned row, unsigned ch) { return 256u * row + 16u * (ch ^ ((row & 7u) << 1)); }
#define VTR(dst, addr, imm) asm volatile("ds_read_b64_tr_b16 %0, %1 offset:%c2" : "=&v"(dst) : "v"(addr), "i"(imm) : "memory")

__device__ __forceinline__ void attn_phase(const Ptrs& P, LAS unsigned char* lds, int G, int bid) {
    const int tid = threadIdx.x, lane = tid & 63, w = __builtin_amdgcn_readfirstlane(tid >> 6), ql = lane & 15, g = lane >> 4;
    const bf16_t* H1 = (const bf16_t*)(P.ws + WS_H1);
    bf16_t* OP = (bf16_t*)(P.ws + WS_OP); float* LSE = (float*)(P.ws + WS_LSE);
    LAS unsigned char* Ks = lds; LAS unsigned char* Vs = lds + 65536;
    const unsigned vbase = (unsigned)(size_t)Vs;
    const int srow = tid >> 4, sch = tid & 15;
    const unsigned soffK = off_k((unsigned)srow, (unsigned)sch), soffV = off_v((unsigned)srow, (unsigned)sch);
    unsigned vb[8];
    { const unsigned q4 = (unsigned)(lane & 15) >> 2, p4 = (unsigned)lane & 3;
#pragma unroll
      for (int c = 0; c < 8; ++c) vb[c] = vbase + off_v(16u * (unsigned)w + 4u * (unsigned)g + q4, 2u * c + (p4 >> 1)) + 8u * (p4 & 1u); }
#define ATT_DECODE(u_, p_, h_, r_, n_, dil_) const int p_ = (u_) >> 9, h_ = ((u_) & 511) >> 6; const int dil_ = 1 << (2 * p_); const int r_ = ((u_) & 63) >> (6 - 2 * p_), n_ = ((u_) & 63) & ((64 >> (2 * p_)) - 1)
    u32x4 kreg[8], vreg[8];
#define ATT_LOAD_TILE(dst, coloff, n_, dil_, r_, h_) do { _Pragma("unroll") for (int i = 0; i < 8; ++i) { dst[i] = (u32x4){0u, 0u, 0u, 0u}; \
        if (!((n_) == 0 && i < 4)) dst[i] = *(const u32x4*)(H1 + (size_t)((128 * ((n_) - 1) + srow + 32 * i) * (dil_) + (r_)) * 4096 + (coloff) + (h_) * 128 + sch * 8); } } while (0)
    { ATT_DECODE(bid, p, h, r, n, dil);
      if (bid < 3 * 512) { ATT_LOAD_TILE(kreg, 1024, n, dil, r, h); ATT_LOAD_TILE(vreg, 2048, n, dil, r, h); } }
    for (int u = bid; u < 3 * 512; u += G) {
        ATT_DECODE(u, p, h, r, n, dil);
#pragma unroll
        for (int i = 0; i < 8; ++i) *(LAS u32x4*)(Ks + soffK + 8192 * i) = kreg[i];
        const bool has_next = (u + G < 3 * 512);
        ATT_DECODE(u + G, p2, h2, r2, n2, dil2);
        if (has_next) ATT_LOAD_TILE(kreg, 1024, n2, dil2, r2, h2);
        const int qpos = (128 * n + 16 * w + ql) * dil + r;
        bf16x8 qf[4];
#pragma unroll
        for (int ks = 0; ks < 4; ++ks) qf[ks] = *(const bf16x8*)(H1 + (size_t)qpos * 4096 + h * 128 + 32 * ks + 8 * g);
        __syncthreads();
        f32x4 s[9];
        __builtin_amdgcn_s_setprio(1);
#pragma unroll
        for (int t = 0; t < 9; ++t) { s[t] = (f32x4){0.f, 0.f, 0.f, 0.f};
#pragma unroll
            for (int ks = 0; ks < 4; ++ks) { const bf16x8 kf = *(const LAS bf16x8*)(Ks + off_k(16 * (w + t) + ql, 4 * ks + g)); s[t] = __builtin_amdgcn_mfma_f32_16x16x32_bf16(kf, qf[ks], s[t], 0, 0, 0); } }
        __builtin_amdgcn_s_setprio(0);
        const float NEG = -INFINITY;
#pragma unroll
        for (int j = 0; j < 4; ++j) { const int kk = 4 * g + j; if (kk < ql) s[0][j] = NEG; if (kk > ql) s[8][j] = NEG; }
        if (n == 0) {
#pragma unroll
            for (int t = 0; t < 8; ++t) if (w + t < 8) s[t] = (f32x4){NEG, NEG, NEG, NEG}; }
        float mx = NEG;
#pragma unroll
        for (int t = 0; t < 9; ++t) mx = fmaxf(mx, fmaxf(fmaxf(s[t][0], s[t][1]), fmaxf(s[t][2], s[t][3])));
        mx = fmaxf(mx, __shfl_xor(mx, 16)); mx = fmaxf(mx, __shfl_xor(mx, 32));
        float l = 0.f;
#pragma unroll
        for (int t = 0; t < 9; ++t) {
#pragma unroll
            for (int j = 0; j < 4; ++j) { const float e = __builtin_amdgcn_exp2f(s[t][j] - mx); s[t][j] = e; l += e; } }
        l += __shfl_xor(l, 16); l += __shfl_xor(l, 32);
#pragma unroll
        for (int i = 0; i < 8; ++i) *(LAS u32x4*)(Vs + soffV + 8192 * i) = vreg[i];
        __syncthreads();
        f32x4 o[8];
#pragma unroll
        for (int c = 0; c < 8; ++c) o[c] = (f32x4){0.f, 0.f, 0.f, 0.f};
#pragma unroll
        for (int kp = 0; kp < 5; ++kp) { const int t0 = 2 * kp, t1 = (2 * kp + 1 < 9) ? 2 * kp + 1 : 2 * kp;
            bf16x8 pf; { const unsigned a = cvt_pk_bf16(s[t0][0], s[t0][1]), b = cvt_pk_bf16(s[t0][2], s[t0][3]);
                unsigned c2 = 0u, d2 = 0u; if (2 * kp + 1 < 9) { c2 = cvt_pk_bf16(s[t1][0], s[t1][1]); d2 = cvt_pk_bf16(s[t1][2], s[t1][3]); }
                const u32x4 pw = (u32x4){a, b, c2, d2}; pf = __builtin_bit_cast(bf16x8, pw); }
            s16x4 lo[8], hi[8];
#pragma unroll
            for (int c = 0; c < 8; ++c) { VTR(lo[c], vb[c], 4096 * t0); VTR(hi[c], vb[c], 4096 * t1); }
            LDS_WAIT(); __builtin_amdgcn_sched_barrier(0); __builtin_amdgcn_s_setprio(1);
#pragma unroll
            for (int c = 0; c < 8; ++c) { const bf16x8 vf = (bf16x8){lo[c][0], lo[c][1], lo[c][2], lo[c][3], hi[c][0], hi[c][1], hi[c][2], hi[c][3]};
                o[c] = __builtin_amdgcn_mfma_f32_16x16x32_bf16(vf, pf, o[c], 0, 0, 0); }
            __builtin_amdgcn_s_setprio(0);
        }
        if (has_next) ATT_LOAD_TILE(vreg, 2048, n2, dil2, r2, h2);
        const float inv = 1.0f / l;
        LAS unsigned char* ost = lds + OST_OFF + w * 2304;
        const int orow = lane >> 2, oseg = lane & 3;
        bf16_t* op = OP + (size_t)p * S * AW + (size_t)((128 * n + 16 * w + orow) * dil + r) * AW + h * 128 + 16 * oseg;
#pragma unroll
        for (int hf = 0; hf < 2; ++hf) {
#pragma unroll
            for (int cc = 0; cc < 4; ++cc) { const int c = 4 * hf + cc; u32x2 wv; wv.x = cvt_pk_bf16(o[c][0] * inv, o[c][1] * inv); wv.y = cvt_pk_bf16(o[c][2] * inv, o[c][3] * inv);
                *(LAS u32x2*)(ost + ql * 144 + cc * 32 + g * 8) = wv; }
            asm volatile("" ::: "memory");
            const u32x4 r0 = *(const LAS u32x4*)(ost + orow * 144 + oseg * 32), r1 = *(const LAS u32x4*)(ost + orow * 144 + oseg * 32 + 16);
            asm volatile("" ::: "memory");
            *(u32x4*)(op + 64 * hf) = r0; *(u32x4*)(op + 64 * hf + 8) = r1;
        }
        if (g == 0) LSE[((size_t)p * S + qpos) * NH + h] = mx + __builtin_amdgcn_logf(l);
    }
    __syncthreads();
    bf16_t* Pp = (bf16_t*)(P.ws + WS_P);
    const int gt = bid * 512 + tid, NGT = G * 512;
    for (int i = gt; i < (S / 32) * 128; i += NGT) { const int ch = i & 127, t0 = (i >> 7) * 32; const int win = 2 << (ch >> 5);
        const bf16_t* src = H1 + (size_t)t0 * 4096 + 3072 + ch * 8;
        float ws8[8];
#pragma unroll
        for (int e = 0; e < 8; ++e) ws8[e] = 0.f;
        for (int j = 1; j <= win; ++j) if (t0 - j >= 0) { const u32x4 y = *(const u32x4*)(src - (size_t)j * 4096);
            ws8[0] += bf_lo(y.x); ws8[1] += bf_hi(y.x); ws8[2] += bf_lo(y.y); ws8[3] += bf_hi(y.y); ws8[4] += bf_lo(y.z); ws8[5] += bf_hi(y.z); ws8[6] += bf_lo(y.w); ws8[7] += bf_hi(y.w); }
#pragma unroll 8
        for (int s = 0; s < 32; ++s) { const int t = t0 + s; const u32x4 x0 = *(const u32x4*)(src + (size_t)s * 4096);
            u32x4 y = (u32x4){0u, 0u, 0u, 0u}; if (t - win >= 0) y = *(const u32x4*)(src + (size_t)(s - win) * 4096);
            const float xs[8] = {bf_lo(x0.x), bf_hi(x0.x), bf_lo(x0.y), bf_hi(x0.y), bf_lo(x0.z), bf_hi(x0.z), bf_lo(x0.w), bf_hi(x0.w)};
            const float ys[8] = {bf_lo(y.x), bf_hi(y.x), bf_lo(y.y), bf_hi(y.y), bf_lo(y.z), bf_hi(y.z), bf_lo(y.w), bf_hi(y.w)};
            const int cnt = (t + 1 < win) ? t + 1 : win; const float ic = 1.0f / (float)cnt;
            float pv[8];
#pragma unroll
            for (int e = 0; e < 8; ++e) { ws8[e] += xs[e] - ys[e]; pv[e] = ws8[e] * ic - xs[e]; }
            u32x4 wv; wv.x = cvt_pk_bf16(pv[0], pv[1]); wv.y = cvt_pk_bf16(pv[2], pv[3]); wv.z = cvt_pk_bf16(pv[4], pv[5]); wv.w = cvt_pk_bf16(pv[6], pv[7]);
            *(u32x4*)(Pp + (size_t)t * AW + ch * 8) = wv; }
    }
}

__device__ __forceinline__ void combine_phase(const Ptrs& P, int G, int bid) {
    const bf16_t* OP = (const bf16_t*)(P.ws + WS_OP); const float* LSE = (const float*)(P.ws + WS_LSE); bf16_t* A3 = (bf16_t*)(P.ws + WS_A3);
    int start, cnt;
    if (G == 256) { start = (bid < 128) ? bid * 2048 : 128 * 2048 + (bid - 128) * 6144; cnt = (bid < 128) ? 2048 : 6144; }
    else { const int per = (S * 128 + G - 1) / G; start = bid * per; cnt = (start + per <= S * 128) ? per : (S * 128 > start ? S * 128 - start : 0); }
    for (int b0 = threadIdx.x; b0 < cnt; b0 += 4 * 512) {
        u32x4 a[4], b[4], c[4]; float l0[4], l1[4], l2[4];
#pragma unroll
        for (int k = 0; k < 4; ++k) { const int ii = b0 + 512 * k; const int i = start + (ii < cnt ? ii : b0); const int t = i >> 7, ch = i & 127, h = ch >> 4;
            l0[k] = LSE[((size_t)0 * S + t) * NH + h]; l1[k] = LSE[((size_t)1 * S + t) * NH + h]; l2[k] = LSE[((size_t)2 * S + t) * NH + h];
            const size_t off = (size_t)t * AW + ch * 8;
            a[k] = __builtin_nontemporal_load((const u32x4*)(OP + off)); b[k] = __builtin_nontemporal_load((const u32x4*)(OP + (size_t)S * AW + off)); c[k] = __builtin_nontemporal_load((const u32x4*)(OP + 2 * (size_t)S * AW + off)); }
#pragma unroll
        for (int k = 0; k < 4; ++k) { const int ii = b0 + 512 * k; if (ii < cnt) { const int i = start + ii; const int t = i >> 7, ch = i & 127;
            const float m = fmaxf(l0[k], fmaxf(l1[k], l2[k])); float w0 = __builtin_amdgcn_exp2f(l0[k] - m), w1 = __builtin_amdgcn_exp2f(l1[k] - m), w2 = __builtin_amdgcn_exp2f(l2[k] - m);
            const float is = 1.0f / (w0 + w1 + w2); w0 *= is; w1 *= is; w2 *= is;
            u32x4 wv;
            wv.x = cvt_pk_bf16(w0 * bf_lo(a[k].x) + w1 * bf_lo(b[k].x) + w2 * bf_lo(c[k].x), w0 * bf_hi(a[k].x) + w1 * bf_hi(b[k].x) + w2 * bf_hi(c[k].x));
            wv.y = cvt_pk_bf16(w0 * bf_lo(a[k].y) + w1 * bf_lo(b[k].y) + w2 * bf_lo(c[k].y), w0 * bf_hi(a[k].y) + w1 * bf_hi(b[k].y) + w2 * bf_hi(c[k].y));
            wv.z = cvt_pk_bf16(w0 * bf_lo(a[k].z) + w1 * bf_lo(b[k].z) + w2 * bf_lo(c[k].z), w0 * bf_hi(a[k].z) + w1 * bf_hi(b[k].z) + w2 * bf_hi(c[k].z));
            wv.w = cvt_pk_bf16(w0 * bf_lo(a[k].w) + w1 * bf_lo(b[k].w) + w2 * bf_lo(c[k].w), w0 * bf_hi(a[k].w) + w1 * bf_hi(b[k].w) + w2 * bf_hi(c[k].w));
            *(u32x4*)(A3 + (size_t)t * DM + ch * 8) = wv; } }
    }
}

__device__ __forceinline__ float wave_sum(float v) {
#pragma unroll
    for (int o = 1; o < 64; o <<= 1) v += __shfl_xor(v, o);
    return v;
}
__device__ __forceinline__ void ln_phase(float* X, const float* gam, const float* bet, bf16_t* xb, int G, int bid) {
    const int lane = threadIdx.x & 63, wave = threadIdx.x >> 6; const int gw = bid * 8 + wave, NGW = G * 8;
    for (int row = gw; row < S; row += NGW) { f32x4* xr = (f32x4*)(X + (size_t)row * DM) + lane;
        f32x4 v[8]; float s = 0.f;
#pragma unroll
        for (int j = 0; j < 8; ++j) { v[j] = xr[64 * j]; s += (v[j][0] + v[j][1]) + (v[j][2] + v[j][3]); }
        const float mean = wave_sum(s) * (1.0f / DM); float s2 = 0.f;
#pragma unroll
        for (int j = 0; j < 8; ++j) { v[j] = v[j] - mean; s2 += (v[j][0] * v[j][0] + v[j][1] * v[j][1]) + (v[j][2] * v[j][2] + v[j][3] * v[j][3]); }
        const float rstd = 1.0f / sqrtf(wave_sum(s2) * (1.0f / DM) + LN_EPS);
#pragma unroll
        for (int j = 0; j < 8; ++j) { const f32x4 gg = *((const f32x4*)gam + lane + 64 * j), bb = *((const f32x4*)bet + lane + 64 * j); const f32x4 y = v[j] * rstd * gg + bb; xr[64 * j] = y;
            if (xb) { u32x2 wv; wv.x = cvt_pk_bf16(y[0], y[1]); wv.y = cvt_pk_bf16(y[2], y[3]); *((u32x2*)(xb + (size_t)row * DM) + lane + 64 * j) = wv; } }
    }
}

struct Args { const void* in[14]; float* out; unsigned char* ws; int ph_lo, ph_hi; };
__global__ void __launch_bounds__(512, 2) mega_fwd(Args a) {
    extern __shared__ __attribute__((aligned(16))) unsigned char lds_raw[];
    LAS unsigned char* lds = (LAS unsigned char*)lds_raw;
    Ptrs P;
    P.x = (const float*)a.in[0]; P.pos = (const int*)a.in[1]; P.w_in = (const float*)a.in[2]; P.w_pool = (const float*)a.in[3]; P.pool_scale = (const float*)a.in[4];
    P.w_ba = (const float*)a.in[5]; P.w_bb = (const float*)a.in[6]; P.w_out = (const float*)a.in[7]; P.ln1g = (const float*)a.in[8]; P.ln1b = (const float*)a.in[9];
    P.w_ff1 = (const float*)a.in[10]; P.w_ff2 = (const float*)a.in[11]; P.ln2g = (const float*)a.in[12]; P.ln2b = (const float*)a.in[13]; P.out = a.out; P.ws = a.ws;
    const int G = gridDim.x, bid = blockIdx.x;
    const int lo = a.ph_lo, hi = a.ph_hi;
    unsigned char* ws = a.ws;
#ifndef PHASE_MASK
#define PHASE_MASK 0x3ff
#endif
#define IN(k) (((PHASE_MASK >> (k)) & 1) && lo <= (k) && (k) < hi)
    volatile LAS unsigned* bst = (volatile LAS unsigned*)(lds + 131072 + 64);
    if (threadIdx.x < 2) bst[threadIdx.x] = 0u;
    __syncthreads();
    XcdBarrier xbar; xbar.bar = (unsigned*)ws; xbar.x = 0; xbar.st = bst;
    xbar = xcd_barrier_post((unsigned*)ws, bst);
#define SEAM(k) do { if (IN(k) && IN((k) + 1)) { if (hi > NPH) cg::this_grid().sync();   else xcd_barrier(xbar); } } while (0)
#ifndef REP_MASK
#define REP_MASK 0
#endif
    if (IN(0)) { p0_prologue<false>(P, lds, G, bid); __syncthreads(); }
    SEAM(0);
    if (REP_MASK & 1024) { xcd_barrier(xbar); xcd_barrier(xbar); xcd_barrier(xbar); xcd_barrier(xbar); }
    if (IN(1)) {
        pg8::Gemm g{(const bf16_t*)(ws + WS_XB), (const bf16_t*)(ws + WS_BT1), DM, DM, DM, 0}; pg8::StaticOrder so; so.init(S, IW, G, bid, 1);
        pg8::Epi1 E{(bf16_t*)(ws + WS_H1), (bf16_t*)(ws + WS_G), (const float*)(ws + WS_COS), (const float*)(ws + WS_SIN)};
        pg8::gemm_phase(lds, g, so, E);
        if (REP_MASK & 2) { __syncthreads(); pg8::gemm_phase(lds, g, so, E); }
    }
    SEAM(1);
    if (IN(2)) { const int vcu = (G % 8 == 0) ? (bid % 8) * (G / 8) + bid / 8 : bid;
        attn_phase(P, lds, G, vcu); if (REP_MASK & 4) { __syncthreads(); attn_phase(P, lds, G, vcu); } }
    SEAM(2);
    if (IN(3)) {
        pg8::Gemm g{(const bf16_t*)(ws + WS_P), (const bf16_t*)(ws + WS_WPT), AW, 256, 256, 512}; pg8::StaticOrder so; so.init(S, 1024, G, bid);
        pg8::EpiBf16<0> E{(bf16_t*)(ws + WS_A3), DM, 1024, nullptr};
        pg8::gemm_phase(lds, g, so, E);
        combine_phase(P, G, bid);
        p0_prologue<true>(P, lds, G, bid);
    }
    SEAM(3);
    if (IN(4)) {
        pg8::Gemm g{(const bf16_t*)(ws + WS_A3), (const bf16_t*)(ws + WS_BT3), DM, 2048, 1024  , 0}; pg8::StaticOrder so; so.init(S, DM, G, bid);
        pg8::Epi3 E{(bf16_t*)(ws + WS_MRG), (const bf16_t*)(ws + WS_G)};
        pg8::gemm_phase(lds, g, so, E);
        if (REP_MASK & 16) { __syncthreads(); pg8::gemm_phase(lds, g, so, E); }
    }
    SEAM(4);
    if (IN(5)) {
        pg8::Gemm g{(const bf16_t*)(ws + WS_MRG), (const bf16_t*)(ws + WS_BT4), DM, DM, DM, 0}; pg8::StaticOrder so; so.init(S, DM, G, bid);
        pg8::EpiResLn<false> E{P.x, nullptr, nullptr, (bf16_t*)(ws + WS_X1B), P.ln1g, P.ln1b, (float*)(ws + WS_ST1), (unsigned*)(ws + 16384)};
        pg8::gemm_phase(lds, g, so, E);
    }
    SEAM(5);
    if (IN(7)) {
        pg8::Gemm g{(const bf16_t*)(ws + WS_X1B), (const bf16_t*)(ws + WS_BT5), DM, DM, DM, 0}; pg8::StaticOrder so; so.init(S, FF, G, bid);
        pg8::EpiBf16<1> E{(bf16_t*)(ws + WS_ACT), FFP, 0, nullptr};
        pg8::gemm_phase(lds, g, so, E);
        if (REP_MASK & 128) { __syncthreads(); pg8::gemm_phase(lds, g, so, E); }
    }
    SEAM(7);
    if (IN(8)) {
        pg8::Gemm g{(const bf16_t*)(ws + WS_ACT), (const bf16_t*)(ws + WS_BT6), FFP, FFP, FF, 0}; pg8::StaticOrder so; so.init(S, DM, G, bid);

        pg8::EpiResLn<true> E{nullptr, (const bf16_t*)(ws + WS_X1B), P.out, nullptr, P.ln2g, P.ln2b, (float*)(ws + WS_ST2), (unsigned*)(ws + 24576)};
        pg8::gemm_phase(lds, g, so, E);
    }
#undef IN
#undef SEAM
}

#ifdef DBG_STOP
__global__ void dbg_dump(const bf16_t* src, float* out, int n) { for (int i = blockIdx.x * blockDim.x + threadIdx.x; i < n; i += gridDim.x * blockDim.x) out[i] = __builtin_bit_cast(float, (unsigned)src[i] << 16); }
#endif
extern "C" void kernel_launch(void* const* d_in, const int* in_sizes, int n_in, void* d_out, int out_size, void* d_ws, size_t ws_size, hipStream_t stream) {
    static int grid = 0;
    if (grid == 0) {
        if (n_in != 14 || out_size != S * DM || ws_size < WS_END) { fprintf(stderr, "kernel_launch: unexpected problem (n_in %d, out %d, ws %zu < %zu)\n", n_in, out_size, ws_size, (size_t)WS_END); grid = -1; return; }
        if (hipFuncSetAttribute((const void*)mega_fwd, hipFuncAttributeMaxDynamicSharedMemorySize, LDS_BYTES) != hipSuccess) { fprintf(stderr, "kernel_launch: hipFuncSetAttribute failed\n"); grid = -1; return; }
        int dev = 0, cus = 0, per_cu = 0;
        hipGetDevice(&dev); hipDeviceGetAttribute(&cus, hipDeviceAttributeMultiprocessorCount, dev);
        hipOccupancyMaxActiveBlocksPerMultiprocessor(&per_cu, (const void*)mega_fwd, 512, LDS_BYTES);
        if (per_cu < 1) { fprintf(stderr, "kernel_launch: occupancy query says %d blocks per CU\n", per_cu); per_cu = 1; }
        (void)hipGetLastError();
        grid = cus;
    }
    if (grid < 0) return;
    Args a{};
    for (int i = 0; i < 14; ++i) a.in[i] = d_in[i];
    a.out = (float*)d_out; a.ws = (unsigned char*)d_ws;
#if N_LAUNCH_MODE == 0
    if (hipMemsetAsync(d_ws, 0, WS_ZERO_BYTES, stream) != hipSuccess) { fprintf(stderr, "kernel_launch: memset of the barrier words failed\n"); return; }
    a.ph_lo = 0; a.ph_hi = NPH;
    void* args[] = {&a};
    hipError_t e = hipLaunchCooperativeKernel((const void*)mega_fwd, dim3(grid), dim3(512), args, LDS_BYTES, stream);
    if (e != hipSuccess) fprintf(stderr, "cooperative launch failed: %s (grid %d)\n", hipGetErrorString(e), grid);
#else
#ifdef DBG_STOP
    for (int ph = 0; ph <= DBG_STOP; ++ph) { a.ph_lo = ph; a.ph_hi = ph + 1; hipLaunchKernelGGL(mega_fwd, dim3(grid), dim3(512), LDS_BYTES, stream, a); }
    hipLaunchKernelGGL(dbg_dump, dim3(2048), dim3(256), 0, stream, (const bf16_t*)((unsigned char*)d_ws + (size_t)DBG_OFF * MiB), (float*)d_out, S * DM);
#else
    for (int ph = 0; ph < NPH; ++ph) { a.ph_lo = ph; a.ph_hi = ph + 1; hipLaunchKernelGGL(mega_fwd, dim3(grid), dim3(512), LDS_BYTES, stream, a); }
#endif
#endif
}
```

```cpp
#include <hip/hip_runtime.h>
#include <hip/hip_cooperative_groups.h>
#include <cstdio>
#include <cstdint>
namespace cg = cooperative_groups;

#ifndef N_LAUNCH_MODE
#define N_LAUNCH_MODE 0
#endif

#define LAS __attribute__((address_space(3)))
typedef unsigned short bf16_t;
typedef short bf16x8 __attribute__((ext_vector_type(8)));
typedef short s16x4 __attribute__((ext_vector_type(4)));
typedef float f32x4 __attribute__((ext_vector_type(4)));
typedef unsigned u32x4 __attribute__((ext_vector_type(4)));
typedef unsigned u32x2 __attribute__((ext_vector_type(2)));

constexpr int S = 8192, DM = 2048, IW = 8192, AW = 1024, FF = 8192, NH = 8;
constexpr float LN_EPS = 1e-5f;
constexpr float ALPHA = 1.189207115002721f;
constexpr float QSCALE = 0.08838834764831845f * 1.4426950408889634f;
constexpr int NPH = 10;

constexpr size_t MiB = 1u << 20;
constexpr size_t WS_ST1 = 65536, WS_ST2 = 82 * MiB + 524288  , WS_ZERO_BYTES = 32768;
static_assert(WS_ST1 + 524288 <= (1u << 20), "control MiB");
constexpr int FFP = FF + 64;
constexpr size_t WS_BT5 = 1 * MiB, WS_BT6 = 33 * MiB, WS_BT3 = 66 * MiB, WS_BT4 = 74 * MiB, WS_WPT = 82 * MiB, WS_COS = 83 * MiB, WS_SIN = 85 * MiB, WS_LSE = 87 * MiB;
constexpr size_t WS_X = 88 * MiB;
constexpr size_t WS_BT1 = WS_X, WS_XB = WS_X + 32 * MiB, WS_OP = WS_X, WS_P = WS_X + 48 * MiB, WS_MRG = WS_X, WS_X1B = WS_X;
constexpr size_t WS_H1 = 152 * MiB, WS_A3 = WS_H1, WS_G = 216 * MiB, WS_ACT = 152 * MiB, WS_END = 281 * MiB;
static_assert(WS_BT6 + (size_t)DM * FFP * 2 <= WS_BT3 && WS_ACT + (size_t)S * FFP * 2 <= WS_END, "workspace map");

constexpr int OST_OFF = 131072 + 1024;
constexpr int LDS_BYTES = OST_OFF + 8 * 2304;

typedef float f32x2_t __attribute__((ext_vector_type(2))); typedef __bf16 bf16x2_t __attribute__((ext_vector_type(2)));
__device__ __forceinline__ unsigned cvt_pk_bf16(float lo, float hi) { f32x2_t v = {lo, hi}; bf16x2_t b = __builtin_convertvector(v, bf16x2_t); return __builtin_bit_cast(unsigned, b); }
__device__ __forceinline__ float bf_lo(unsigned w) { return __builtin_bit_cast(float, w << 16); }
__device__ __forceinline__ float bf_hi(unsigned w) { return __builtin_bit_cast(float, w & 0xffff0000u); }
#define LDS_WAIT() asm volatile("s_waitcnt lgkmcnt(0)" ::: "memory")

#define XB_TMO      128
#define XB_XCNT(j)  (256  + 64 * (j))
#define XB_XSUB(j)  (1280 + 64 * (j))
#define XB_XGEN(j)  (2304 + 64 * (j))
#define XB_TOP      3328
#define XB_TOPGEN   3392
#define XCD_BAR_WORDS 3456
#define XB_SPIN_CAP (1u << 22)
__device__ __forceinline__ unsigned xb_ld(unsigned* p)              { return __hip_atomic_load(p, __ATOMIC_RELAXED, __HIP_MEMORY_SCOPE_AGENT); }
__device__ __forceinline__ unsigned xb_add(unsigned* p, unsigned v) { return __hip_atomic_fetch_add(p, v, __ATOMIC_RELAXED, __HIP_MEMORY_SCOPE_AGENT); }
__device__ __forceinline__ unsigned xb_xcc_id() { return (unsigned)__builtin_amdgcn_s_getreg((3 << 11) | 20) & 0xFu; }
#define XB_SPIN(cond, bar) do { unsigned _sp = 0; while (cond) { __builtin_amdgcn_s_sleep(1); \
    if ((++_sp & 255u) == 0u) { if (xb_ld(&(bar)[XB_TMO])) break; if (_sp > XB_SPIN_CAP) { atomicAdd(&(bar)[XB_TMO], 1u); break; } } } } while (0)
struct XcdBarrier { unsigned* bar; unsigned x; volatile LAS unsigned* st; };
__device__ __forceinline__ XcdBarrier xcd_barrier_post(unsigned* bar, volatile LAS unsigned* st) {
    XcdBarrier b; b.bar = bar; b.x = xb_xcc_id(); b.st = st;
    if (threadIdx.x == 0) (void)xb_add(&bar[XB_XCNT(b.x)], 1u);
    return b;
}
__device__ __forceinline__ void xcd_barrier_complete(unsigned* bar, unsigned x, unsigned& nloc, unsigned& nx) {
    const unsigned G = gridDim.x * gridDim.y * gridDim.z;
    unsigned sum, cnt, mine, sp = 0u;
    for (;;) {
        sum = 0u; cnt = 0u; mine = 0u;
#pragma unroll
        for (unsigned j = 0; j < 16; ++j) { const unsigned c = xb_ld(&bar[XB_XCNT(j)]); sum += c; cnt += (c > 0u) ? 1u : 0u; mine = (j == x) ? c : mine; }
        if (sum == G) break;
        __builtin_amdgcn_s_sleep(1);
        if ((++sp & 255u) == 0u) { if (xb_ld(&bar[XB_TMO])) break; if (sp > XB_SPIN_CAP) { atomicAdd(&bar[XB_TMO], 1u); break; } }
    }
    nloc = mine > 0u ? mine : 1u; nx = cnt > 0u ? cnt : 1u;
}
__device__ __forceinline__ void xcd_barrier(const XcdBarrier& b) {
    asm volatile("s_waitcnt vmcnt(0)" ::: "memory");
    __syncthreads();
    if (threadIdx.x == 0) {
        unsigned* bar = b.bar;
        __builtin_amdgcn_s_waitcnt(0);
        unsigned nloc = b.st[0], nx = b.st[1];
        if (nloc == 0u) { xcd_barrier_complete(bar, b.x, nloc, nx); b.st[0] = nloc; b.st[1] = nx; }
        const unsigned old = xb_add(&bar[XB_XSUB(b.x)], 1u);
        const unsigned gen = old / nloc;
        if (old + 1u == (gen + 1u) * nloc) {
            __builtin_amdgcn_fence(__ATOMIC_RELEASE, "agent");
            asm volatile("s_waitcnt vmcnt(0)" ::: "memory");
            const unsigned og = xb_add(&bar[XB_TOP], 1u);
            const unsigned tg = og / nx;
            if (og + 1u == (tg + 1u) * nx) xb_add(&bar[XB_TOPGEN], 1u);
            else XB_SPIN(xb_ld(&bar[XB_TOPGEN]) == tg, bar);
            __builtin_amdgcn_fence(__ATOMIC_ACQUIRE, "agent");
            xb_add(&bar[XB_XGEN(b.x)], 1u);
            asm volatile("s_waitcnt vmcnt(0)" ::: "memory");
        } else {
            XB_SPIN(xb_ld(&bar[XB_XGEN(b.x)]) == gen, bar);
            __builtin_amdgcn_fence(__ATOMIC_ACQUIRE, "agent");
            asm volatile("s_waitcnt vmcnt(0)" ::: "memory");
        }
    }
    __syncthreads();
}

namespace pg8 {
constexpr int BM = 256, BK = 64, HALF = 128, HTB = HALF * BK * 2, NXCD = 8, WGM = 4;
__host__ __device__ __forceinline__ int lds_byte(int r, int c) { const int st = (r >> 4) * 2 + (c >> 5), rr = r & 15, cc = c & 31, ob = rr * 64 + cc * 2; return st * 1024 + (ob ^ (((ob >> 9) & 1) << 5)); }
__host__ __device__ __forceinline__ void stage_rc(int b, int& R, int& C) { const int st = b / 1024, sb = b % 1024, swz = sb ^ (((sb >> 9) & 1) << 5); R = (st >> 1) * 16 + swz / 64; C = (st & 1) * 32 + (swz % 64) / 2; }
__host__ __device__ __forceinline__ int perm32(int rho) { const int n = rho >> 4, i = rho & 15; return 8 * (i >> 2) + 4 * n + (i & 3); }

struct Unit { int pm, pn; };
struct Gemm { const bf16_t* A; const bf16_t* Bt; int lda, ldb, K, apn; };

struct StaticOrder {
    int nM, nN, nwg, G, c, mix;
    __device__ void init(int M, int N, int G_, int c_, int mix_ = 0) { nM = M / BM; nN = N / BM; nwg = nM * nN; G = G_; c = c_; mix = mix_; }
    __device__ bool next(int i, Unit& u) const {
        const long L = (long)i * G + c; if (L >= nwg) return false;
        int wgid = (int)L; { const int q = nwg / NXCD, r = nwg % NXCD, xcd = wgid % NXCD, off = wgid / NXCD; wgid = (xcd < r ? xcd * (q + 1) : r * (q + 1) + (xcd - r) * q) + off; }
        const int nig = WGM * nN, gid = wgid / nig, fm = gid * WGM, gsz = (nM - fm) < WGM ? (nM - fm) : WGM;
        u.pm = fm + ((wgid % nig) % gsz); u.pn = (wgid % nig) / gsz;
        if (mix) { const int j = u.pn; u.pn = 16 * ((j >> 3) & 1) + 8 * ((j >> 4) & 1) + (j & 7); }
        return true;
    }
};

typedef f32x4 Acc[2][2][4][2];

template <class Epi>
__device__ __forceinline__ void gemm_phase(LAS unsigned char* lds, const Gemm g, const StaticOrder& S, const Epi& E) {
    const int tid = threadIdx.x, wid = __builtin_amdgcn_readfirstlane(tid >> 6), lane = tid & 63, wr = wid >> 2, wc = wid & 3, fr = lane & 15, fq = lane >> 4;
    const int K = g.K, nt = K / BK;
    unsigned voffA[2], voffB[2];
#pragma unroll
    for (int i = 0; i < 2; ++i) { int R, C; stage_rc(tid * 16 + i * 8192, R, C); const int Rb = Epi::PERM ? ((R & ~31) + perm32(R & 31)) : R;
        voffA[i] = (unsigned)(R * g.lda + C) * 2u; voffB[i] = (unsigned)(Rb * g.ldb + C) * 2u; }
    const size_t kstep = (size_t)(BK * 2);
    const size_t hstepA = (size_t)HALF * g.lda * 2, hstepB = (size_t)HALF * g.ldb * 2;
    const size_t tstepA = 2 * hstepA, tstepB = 2 * hstepB;
    const unsigned ldsw = (unsigned)wid * 1024u;
    const int aoff = lds_byte(wr * 64 + fr, fq * 8), boff = lds_byte(wc * 32 + fr, fq * 8);
#define PG8_SA(b, h) (((b) * 2 + (h)) * HTB)
#define PG8_SB(b, h) ((4 + (b) * 2 + (h)) * HTB)
#define PG8_STAGE(bufoff, gbase, voff) do { _Pragma("unroll") for (int _i = 0; _i < 2; ++_i) \
        __builtin_amdgcn_global_load_lds((const unsigned*)((const char*)(gbase) + (voff)[_i]), (LAS unsigned*)(lds + (bufoff) + ldsw + _i * 8192), 16, 0, 0); } while (0)
#define PG8_LDA(dst, b, h) do { _Pragma("unroll") for (int m = 0; m < 4; ++m) _Pragma("unroll") for (int k = 0; k < 2; ++k) dst[m][k] = *(const LAS bf16x8*)(lds + PG8_SA(b, h) + aoff + m * 2048 + k * 1024); } while (0)
#define PG8_LDB(dst, b, h) do { _Pragma("unroll") for (int n = 0; n < 2; ++n) _Pragma("unroll") for (int k = 0; k < 2; ++k) dst[n][k] = *(const LAS bf16x8*)(lds + PG8_SB(b, h) + boff + n * 2048 + k * 1024); } while (0)
#define PG8_MMA(ai, bj, At, Bt) do { __builtin_amdgcn_s_setprio(1); _Pragma("unroll") for (int m = 0; m < 4; ++m) _Pragma("unroll") for (int n = 0; n < 2; ++n) _Pragma("unroll") for (int k = 0; k < 2; ++k) \
        acc[ai][bj][m][n] = __builtin_amdgcn_mfma_f32_16x16x32_bf16(Bt[n][k], At[m][k], acc[ai][bj][m][n], 0, 0, 0); __builtin_amdgcn_s_setprio(0); } while (0)
#define PG8_WAIT_V(n) asm volatile("s_waitcnt vmcnt(" #n ")" ::: "memory")
#define PG8_WAIT_L(n) asm volatile("s_waitcnt lgkmcnt(" #n ")" ::: "memory")
#define PG8_BAR __builtin_amdgcn_s_barrier()
#define PG8_SCHED __builtin_amdgcn_sched_barrier(0)
    Unit cur, nxt; int ui = 0;
#define PG8_NEXT(i, u) (Epi::MID ? S.next((i) >> 1, u) : S.next((i), u))
#define PG8_KOFF(i) (Epi::MID ? (size_t)((i) & 1) * (size_t)K * 2 : (size_t)0)
    if (!PG8_NEXT(0, cur)) return;
    Acc acc;
#pragma unroll
    for (int a = 0; a < 2; ++a)
#pragma unroll
        for (int b = 0; b < 2; ++b)
#pragma unroll
            for (int m = 0; m < 4; ++m)
#pragma unroll
                for (int n = 0; n < 2; ++n) acc[a][b][m][n] = (f32x4){0.f, 0.f, 0.f, 0.f};
    bf16x8 At[4][2], B0[2][2], B1[2][2];
    const char* cA = (const char*)g.A + (size_t)cur.pm * tstepA + (size_t)cur.pn * g.apn + PG8_KOFF(0); const char* cB = (const char*)g.Bt + (size_t)cur.pn * tstepB + PG8_KOFF(0);
    PG8_STAGE(PG8_SB(0, 0), cB, voffB); PG8_STAGE(PG8_SB(0, 1), cB + hstepB, voffB); PG8_STAGE(PG8_SA(0, 0), cA, voffA); PG8_STAGE(PG8_SA(0, 1), cA + hstepA, voffA);
    if (wr == 1) PG8_BAR;
    PG8_WAIT_V(2); PG8_BAR;
    PG8_STAGE(PG8_SB(1, 0), cB + kstep, voffB); PG8_STAGE(PG8_SA(1, 0), cA + kstep, voffA); PG8_STAGE(PG8_SB(1, 1), cB + hstepB + kstep, voffB);
    PG8_WAIT_V(6); PG8_BAR;
    for (;;) {
        const bool has_next = PG8_NEXT(ui + 1, nxt);
        const char* nA = has_next ? (const char*)g.A + (size_t)nxt.pm * tstepA + (size_t)nxt.pn * g.apn + PG8_KOFF(ui + 1) : cA; const char* nB = has_next ? (const char*)g.Bt + (size_t)nxt.pn * tstepB + PG8_KOFF(ui + 1) : cB;
#pragma nounroll
        for (int t = 0; t < nt; t += 2) {
            const bool last = (t == nt - 2);
            const char* a1 = cA + (size_t)(t + 1) * kstep;
            const char* a2 = last ? nA : cA + (size_t)(t + 2) * kstep; const char* b2 = last ? nB : cB + (size_t)(t + 2) * kstep;
            const char* a3 = a2 + kstep; const char* b3 = b2 + kstep;
            PG8_LDB(B0, 0, 0); PG8_LDB(B1, 0, 1); PG8_SCHED; PG8_LDA(At, 0, 0); PG8_STAGE(PG8_SA(1, 1), a1 + hstepA, voffA);
            PG8_WAIT_V(8); PG8_WAIT_L(0); PG8_BAR; PG8_MMA(0, 0, At, B0); PG8_MMA(0, 1, At, B1); PG8_BAR; PG8_SCHED;
            PG8_LDA(At, 0, 1); PG8_STAGE(PG8_SB(0, 0), b2, voffB); PG8_STAGE(PG8_SB(0, 1), b2 + hstepB, voffB); PG8_STAGE(PG8_SA(0, 0), a2, voffA);
            PG8_WAIT_V(8); PG8_WAIT_L(0); PG8_BAR; PG8_MMA(1, 0, At, B0); PG8_MMA(1, 1, At, B1); PG8_BAR; PG8_SCHED;
            PG8_LDB(B0, 1, 0); PG8_LDB(B1, 1, 1); PG8_SCHED; PG8_LDA(At, 1, 0); PG8_STAGE(PG8_SA(0, 1), a2 + hstepA, voffA);
            PG8_WAIT_V(8); PG8_WAIT_L(0); PG8_BAR; PG8_MMA(0, 0, At, B0); PG8_MMA(0, 1, At, B1); PG8_BAR; PG8_SCHED;
            PG8_LDA(At, 1, 1); PG8_STAGE(PG8_SB(1, 0), b3, voffB); PG8_STAGE(PG8_SB(1, 1), b3 + hstepB, voffB); PG8_STAGE(PG8_SA(1, 0), a3, voffA);
            PG8_WAIT_V(8); PG8_WAIT_L(0); PG8_BAR; PG8_MMA(1, 0, At, B0); PG8_MMA(1, 1, At, B1); PG8_BAR; PG8_SCHED;
        }
        if (wr == 0) PG8_BAR;
        bool fin = true;
        if constexpr (Epi::MID) { if ((ui & 1) == 0) { E.mid(acc, cur, wr, wc, fr, fq); fin = false; } }
        if constexpr (!Epi::FUSED) { if (fin) E(acc, cur, wr, wc, fr, fq); }
        if (!has_next) break;
        if (fin) {
#pragma unroll
        for (int a = 0; a < 2; ++a)
#pragma unroll
            for (int b = 0; b < 2; ++b)
#pragma unroll
                for (int m = 0; m < 4; ++m)
#pragma unroll
                    for (int n = 0; n < 2; ++n) acc[a][b][m][n] = (f32x4){0.f, 0.f, 0.f, 0.f};
        }
        cur = nxt; cA = nA; cB = nB; ++ui;
        if (wr == 1) PG8_BAR;
    }
    PG8_WAIT_V(0);
    PG8_BAR;
    if constexpr (Epi::FUSED) E.fused(acc, cur, wr, wc, fr, fq, lds);
#undef PG8_NEXT
#undef PG8_KOFF
#undef PG8_SA
#undef PG8_SB
#undef PG8_STAGE
#undef PG8_LDA
#undef PG8_LDB
#undef PG8_MMA
#undef PG8_WAIT_V
#undef PG8_WAIT_L
#undef PG8_BAR
#undef PG8_SCHED
}

struct Epi1 {
    static constexpr bool PERM = true, MID = false, FUSED = false;
    bf16_t* H1; bf16_t* G; const float* cosT; const float* sinT;
    __device__ __forceinline__ void operator()(const Acc& acc, const Unit& u, int wr, int wc, int fr, int fq) const {
        const int row0 = u.pm * BM + wr * 64 + fr;
        if (u.pn < 8) {
            const float sc = (u.pn < 4) ? QSCALE : 1.0f;
            const int d0 = 16 * wc + 4 * fq;
#pragma unroll
            for (int ai = 0; ai < 2; ++ai)
#pragma unroll
                for (int m = 0; m < 4; ++m) { const int row = row0 + ai * HALF + m * 16;
                    const f32x4 cs = *(const f32x4*)(cosT + (size_t)row * 64 + d0) * sc, sn = *(const f32x4*)(sinT + (size_t)row * 64 + d0) * sc;
#pragma unroll
                    for (int bj = 0; bj < 2; ++bj) { const f32x4 v0 = acc[ai][bj][m][0], v1 = acc[ai][bj][m][1];
                        const f32x4 lo = v0 * cs - v1 * sn, hi = v1 * cs + v0 * sn;
                        bf16_t* p = H1 + (size_t)row * 4096 + u.pn * BM + bj * HALF + d0;
                        u32x2 a, b; a.x = cvt_pk_bf16(lo[0], lo[1]); a.y = cvt_pk_bf16(lo[2], lo[3]); b.x = cvt_pk_bf16(hi[0], hi[1]); b.y = cvt_pk_bf16(hi[2], hi[3]);
                        *(u32x2*)p = a; *(u32x2*)(p + 64) = b; } }
        } else if (u.pn < 16) {
            const int col0 = u.pn * BM + wc * 32 + 8 * fq;
#pragma unroll
            for (int ai = 0; ai < 2; ++ai)
#pragma unroll
                for (int m = 0; m < 4; ++m) { bf16_t* rowp = H1 + (size_t)(row0 + ai * HALF + m * 16) * 4096 + col0;
#pragma unroll
                    for (int bj = 0; bj < 2; ++bj) { const f32x4 v0 = acc[ai][bj][m][0], v1 = acc[ai][bj][m][1];
                        u32x4 w; w.x = cvt_pk_bf16(v0[0], v0[1]); w.y = cvt_pk_bf16(v0[2], v0[3]); w.z = cvt_pk_bf16(v1[0], v1[1]); w.w = cvt_pk_bf16(v1[2], v1[3]);
                        *(u32x4*)(rowp + bj * HALF) = w; } }
        } else {
            const int col0 = (u.pn - 16) * BM + wc * 32 + 8 * fq;
#pragma unroll
            for (int ai = 0; ai < 2; ++ai)
#pragma unroll
                for (int m = 0; m < 4; ++m) { bf16_t* rowp = G + (size_t)(row0 + ai * HALF + m * 16) * 4096 + col0;
#pragma unroll
                    for (int bj = 0; bj < 2; ++bj) { f32x4 v0 = acc[ai][bj][m][0], v1 = acc[ai][bj][m][1];
#pragma unroll
                        for (int j = 0; j < 4; ++j) { v0[j] = __builtin_amdgcn_rcpf(1.0f + __expf(-fmaxf(v0[j], -60.f))); v1[j] = __builtin_amdgcn_rcpf(1.0f + __expf(-fmaxf(v1[j], -60.f))); }
                        u32x4 w; w.x = cvt_pk_bf16(v0[0], v0[1]); w.y = cvt_pk_bf16(v0[2], v0[3]); w.z = cvt_pk_bf16(v1[0], v1[1]); w.w = cvt_pk_bf16(v1[2], v1[3]);
                        __builtin_nontemporal_store(w, (u32x4*)(rowp + bj * HALF)); } }
        }
    }
};
template <int ACT> struct EpiBf16 {
    static constexpr bool PERM = true, MID = false, FUSED = false;
    bf16_t* O; int ldc; int coloff; const float* scale;
    __device__ __forceinline__ void operator()(const Acc& acc, const Unit& u, int wr, int wc, int fr, int fq) const {
        const int row0 = u.pm * BM + wr * 64 + fr, col0 = u.pn * BM + wc * 32 + 8 * fq;
#pragma unroll
        for (int ai = 0; ai < 2; ++ai)
#pragma unroll
            for (int m = 0; m < 4; ++m) { bf16_t* rowp = O + (size_t)(row0 + ai * HALF + m * 16) * ldc + coloff + col0;
#pragma unroll
                for (int bj = 0; bj < 2; ++bj) { f32x4 v0 = acc[ai][bj][m][0], v1 = acc[ai][bj][m][1];
                    if (ACT == 1) {
#pragma unroll
                        for (int j = 0; j < 4; ++j) { const float a = fmaxf(v0[j], 0.f), b = fmaxf(v1[j], 0.f); v0[j] = a * a; v1[j] = b * b; } }
                    if (ACT == 2) { v0 = v0 * *(const f32x4*)(scale + col0 + bj * HALF); v1 = v1 * *(const f32x4*)(scale + col0 + bj * HALF + 4); }
                    u32x4 w; w.x = cvt_pk_bf16(v0[0], v0[1]); w.y = cvt_pk_bf16(v0[2], v0[3]); w.z = cvt_pk_bf16(v1[0], v1[1]); w.w = cvt_pk_bf16(v1[2], v1[3]);
                    *(u32x4*)(rowp + bj * HALF) = w; }
                if (ACT == 2) asm volatile("" ::: "memory"); }
    }
};
struct Epi3 {
    static constexpr bool PERM = true, MID = true, FUSED = false;
    bf16_t* O; const bf16_t* G;
    __device__ __forceinline__ void mid(Acc& acc, const Unit& u, int wr, int wc, int fr, int fq) const {
        const int row0 = u.pm * BM + wr * 64 + fr, col0 = u.pn * BM + wc * 32 + 8 * fq;
#pragma unroll
        for (int ai = 0; ai < 2; ++ai)
#pragma unroll
            for (int m = 0; m < 4; ++m) { const bf16_t* gp = G + (size_t)(row0 + ai * HALF + m * 16) * 4096 + col0;
#pragma unroll
                for (int bj = 0; bj < 2; ++bj) { const u32x4 a = __builtin_nontemporal_load((const u32x4*)(gp + bj * HALF)), b = *(const u32x4*)(gp + 2048 + bj * HALF);
                    f32x4 r0, r1;
                    r0[0] = bf_lo(a.x) * __builtin_amdgcn_rcpf(bf_lo(b.x)); r0[1] = bf_hi(a.x) * __builtin_amdgcn_rcpf(bf_hi(b.x)); r0[2] = bf_lo(a.y) * __builtin_amdgcn_rcpf(bf_lo(b.y)); r0[3] = bf_hi(a.y) * __builtin_amdgcn_rcpf(bf_hi(b.y));
                    r1[0] = bf_lo(a.z) * __builtin_amdgcn_rcpf(bf_lo(b.z)); r1[1] = bf_hi(a.z) * __builtin_amdgcn_rcpf(bf_hi(b.z)); r1[2] = bf_lo(a.w) * __builtin_amdgcn_rcpf(bf_lo(b.w)); r1[3] = bf_hi(a.w) * __builtin_amdgcn_rcpf(bf_hi(b.w));
                    acc[ai][bj][m][0] = acc[ai][bj][m][0] * r0; acc[ai][bj][m][1] = acc[ai][bj][m][1] * r1; }
                asm volatile("" ::: "memory"); }
    }
    __device__ __forceinline__ void operator()(const Acc& acc, const Unit& u, int wr, int wc, int fr, int fq) const {
        const int row0 = u.pm * BM + wr * 64 + fr, col0 = u.pn * BM + wc * 32 + 8 * fq;
#pragma unroll
        for (int ai = 0; ai < 2; ++ai)
#pragma unroll
            for (int m = 0; m < 4; ++m) { const size_t row = (size_t)(row0 + ai * HALF + m * 16); const bf16_t* gp = G + row * 4096 + 2048 + col0; bf16_t* rowp = O + row * DM + col0;
#pragma unroll
                for (int bj = 0; bj < 2; ++bj) { const u32x4 b = __builtin_nontemporal_load((const u32x4*)(gp + bj * HALF)); const f32x4 v0 = acc[ai][bj][m][0], v1 = acc[ai][bj][m][1];
                    u32x4 w; w.x = cvt_pk_bf16(v0[0] * bf_lo(b.x), v0[1] * bf_hi(b.x)); w.y = cvt_pk_bf16(v0[2] * bf_lo(b.y), v0[3] * bf_hi(b.y));
                    w.z = cvt_pk_bf16(v1[0] * bf_lo(b.z), v1[1] * bf_hi(b.z)); w.w = cvt_pk_bf16(v1[2] * bf_lo(b.w), v1[3] * bf_hi(b.w));
                    *(u32x4*)(rowp + bj * HALF) = w; }
                asm volatile("" ::: "memory"); }
    }
};
struct EpiRes {
    static constexpr bool PERM = false, MID = false, FUSED = false;
    const float* base; float* out;
    __device__ __forceinline__ void operator()(const Acc& acc, const Unit& u, int wr, int wc, int fr, int fq) const {
        const int row0 = u.pm * BM + wr * 64 + fr, col0 = u.pn * BM + wc * 32 + 4 * fq;
#pragma unroll
        for (int ai = 0; ai < 2; ++ai)
#pragma unroll
            for (int m = 0; m < 4; ++m) { const size_t off = (size_t)(row0 + ai * HALF + m * 16) * DM + col0;
#pragma unroll
                for (int bj = 0; bj < 2; ++bj)
#pragma unroll
                    for (int n = 0; n < 2; ++n) { const f32x4 bs = *(const f32x4*)(base + off + bj * HALF + n * 16); *(f32x4*)(out + off + bj * HALF + n * 16) = bs * ALPHA + acc[ai][bj][m][n]; } }
    }
};
template <bool BASE_BF16> struct EpiResLn {
    static constexpr bool PERM = false, MID = false, FUSED = true;
    const float* base; const bf16_t* baseb; float* out; bf16_t* xb; const float* gam; const float* bet; float* stats; unsigned* cnt;
    __device__ __forceinline__ void operator()(const Acc&, const Unit&, int, int, int, int) const {}
    __device__ __forceinline__ void fused(Acc& acc, const Unit& u, int wr, int wc, int fr, int fq, LAS unsigned char* lds) const {
        const int row0 = u.pm * BM + wr * 64 + fr, col0 = u.pn * BM + wc * 32 + 4 * fq;
        LAS float* Pst = (LAS float*)lds;
#pragma unroll
        for (int ai = 0; ai < 2; ++ai)
#pragma unroll
            for (int m = 0; m < 4; ++m) { const size_t off = (size_t)(row0 + ai * HALF + m * 16) * DM + col0; float s = 0.f, q = 0.f;
#pragma unroll
                for (int bj = 0; bj < 2; ++bj)
#pragma unroll
                    for (int n = 0; n < 2; ++n) { f32x4 bs; if (BASE_BF16) { const u32x2 wb = *(const u32x2*)(baseb + off + bj * HALF + n * 16); bs = (f32x4){bf_lo(wb.x), bf_hi(wb.x), bf_lo(wb.y), bf_hi(wb.y)}; } else bs = __builtin_nontemporal_load((const f32x4*)(base + off + bj * HALF + n * 16));
                        const f32x4 v = bs * ALPHA + acc[ai][bj][m][n]; acc[ai][bj][m][n] = v;
                        s += (v[0] + v[1]) + (v[2] + v[3]); q += (v[0] * v[0] + v[1] * v[1]) + (v[2] * v[2] + v[3] * v[3]); }
                s += __shfl_xor(s, 16); s += __shfl_xor(s, 32); q += __shfl_xor(q, 16); q += __shfl_xor(q, 32);
                if (fq == 0) { const int rl = ai * HALF + wr * 64 + m * 16 + fr; Pst[(rl * 4 + wc) * 2] = s; Pst[(rl * 4 + wc) * 2 + 1] = q; }
                asm volatile("" ::: "memory"); }
        __syncthreads();
        if (threadIdx.x < 256) { const int rl = threadIdx.x; float s = 0.f, q = 0.f;
#pragma unroll
            for (int w = 0; w < 4; ++w) { s += Pst[(rl * 4 + w) * 2]; q += Pst[(rl * 4 + w) * 2 + 1]; }
            unsigned long long* st = (unsigned long long*)stats + ((size_t)(u.pm * BM + rl) * 8 + u.pn);
            __hip_atomic_store(st, ((unsigned long long)__float_as_uint(q) << 32) | __float_as_uint(s), __ATOMIC_RELAXED, __HIP_MEMORY_SCOPE_AGENT); }
        asm volatile("s_waitcnt vmcnt(0)" ::: "memory");
        __syncthreads();
        if (threadIdx.x == 0) { unsigned* c = cnt + 64 * u.pm; (void)xb_add(c, 1u); unsigned sp = 0u;
            while (xb_ld(c) < 8u) { __builtin_amdgcn_s_sleep(1); if (++sp > XB_SPIN_CAP) break; } }
        __syncthreads();
        LAS float* Sst = (LAS float*)(lds + 8192);
        if (threadIdx.x < 256) { const int rl = threadIdx.x; const unsigned long long* st = (const unsigned long long*)stats + (size_t)(u.pm * BM + rl) * 8; float s = 0.f, q = 0.f;
#pragma unroll
            for (int t = 0; t < 8; ++t) { const unsigned long long v = __hip_atomic_load(st + t, __ATOMIC_RELAXED, __HIP_MEMORY_SCOPE_AGENT); s += __uint_as_float((unsigned)v); q += __uint_as_float((unsigned)(v >> 32)); }
            const float mean = s * (1.0f / DM); const float var = fmaxf(q * (1.0f / DM) - mean * mean, 0.f);
            Sst[rl * 2] = mean; Sst[rl * 2 + 1] = 1.0f / sqrtf(var + LN_EPS); }
        __syncthreads();
#pragma unroll
        for (int ai = 0; ai < 2; ++ai)
#pragma unroll
            for (int m = 0; m < 4; ++m) { const int row = row0 + ai * HALF + m * 16; const size_t off = (size_t)row * DM + col0;
                const int rl = ai * HALF + wr * 64 + m * 16 + fr; const float mean = Sst[rl * 2], rstd = Sst[rl * 2 + 1];
#pragma unroll
                for (int bj = 0; bj < 2; ++bj)
#pragma unroll
                    for (int n = 0; n < 2; ++n) { const int c = col0 + bj * HALF + n * 16; const f32x4 gg = *(const f32x4*)(gam + c), bb = *(const f32x4*)(bet + c);
                        const f32x4 y = (acc[ai][bj][m][n] - mean) * rstd * gg + bb; if (out) __builtin_nontemporal_store(y, (f32x4*)(out + off + bj * HALF + n * 16));
                        if (xb) { u32x2 wv; wv.x = cvt_pk_bf16(y[0], y[1]); wv.y = cvt_pk_bf16(y[2], y[3]); *(u32x2*)(xb + off + bj * HALF + n * 16) = wv; } }
                asm volatile("" ::: "memory"); }
    }
};
}

__device__ __forceinline__ int rope_permd(int d) { return 8 * ((d & 63) >> 2) + 4 * (d >> 6) + (d & 3); }
__device__ __forceinline__ void transpose_item(const float* W, int N, bf16_t* WT, int ldw, int coloff, int row_off, bool rope, LAS float* scr, int kb, int nb, int lane, const float* rscale = nullptr) {
    const int k0 = 64 * kb, n0 = 64 * nb;
    const int lk = lane >> 4, n4 = 4 * (lane & 15);
    f32x4 tv[16];
#pragma unroll
    for (int i = 0; i < 16; ++i) tv[i] = __builtin_nontemporal_load((const f32x4*)(W + (size_t)(k0 + 4 * i + lk) * N + n0 + n4));
#pragma unroll
    for (int i = 0; i < 16; ++i) { const int k = 4 * i + lk; *(LAS f32x4*)(scr + k * 64 + (n4 ^ (4 * (k >> 3)))) = tv[i]; }
    LDS_WAIT(); asm volatile("" ::: "memory");
    const int c = lane & 7;
#pragma unroll
    for (int j = 0; j < 8; ++j) { const int n = (lane >> 3) + 8 * j; const LAS float* s = scr + (8 * c) * 64 + (n ^ (4 * c));
        const float rs = rscale ? rscale[n0 + n] : 1.0f;
        u32x4 o; o.x = cvt_pk_bf16(s[0 * 64] * rs, s[1 * 64] * rs); o.y = cvt_pk_bf16(s[2 * 64] * rs, s[3 * 64] * rs); o.z = cvt_pk_bf16(s[4 * 64] * rs, s[5 * 64] * rs); o.w = cvt_pk_bf16(s[6 * 64] * rs, s[7 * 64] * rs);
        const int ncol = n0 + n; const int drow = (rope && ncol < 2048) ? ((ncol & ~127) + rope_permd(ncol & 127)) : ncol;
        *(u32x4*)(WT + (size_t)(row_off + drow) * ldw + coloff + k0 + 8 * c) = o; }
    LDS_WAIT(); asm volatile("" ::: "memory");
}

struct Ptrs {
    const float *x, *w_in, *w_pool, *pool_scale, *w_ba, *w_bb, *w_out, *ln1g, *ln1b, *w_ff1, *w_ff2, *ln2g, *ln2b; const int* pos;
    float* out; unsigned char* ws;
};

template <bool late> __device__ __forceinline__ void p0_prologue(const Ptrs& P, LAS unsigned char* lds, int G, int bid) {
    const int tid = threadIdx.x, lane = tid & 63, wave = __builtin_amdgcn_readfirstlane(tid >> 6);
    LAS float* scr = (LAS float*)(lds + wave * 16384);
    const int gw = bid * 8 + wave, NGW = G * 8;
    bf16_t* Bt1 = (bf16_t*)(P.ws + WS_BT1); bf16_t* Bt3 = (bf16_t*)(P.ws + WS_BT3); bf16_t* Bt4 = (bf16_t*)(P.ws + WS_BT4); bf16_t* Bt5 = (bf16_t*)(P.ws + WS_BT5); bf16_t* Bt6 = (bf16_t*)(P.ws + WS_BT6); bf16_t* WpT = (bf16_t*)(P.ws + WS_WPT);
    constexpr int I_IN = (DM / 64) * (IW / 64), I_PL = 4 * (256 / 64) * (256 / 64), I_BA = (AW / 64) * (DM / 64), I_OUT = (DM / 64) * (DM / 64), I_F1 = (DM / 64) * (FF / 64), I_F2 = (FF / 64) * (DM / 64);
    constexpr int NITEMS = late ? (2 * I_BA + I_OUT + I_F1 + I_F2) : (I_IN + I_PL);
    for (int it = gw; it < NITEMS; it += NGW) {
        int r = it;
        if (late) {
            if (r < I_BA) { transpose_item(P.w_ba, DM, Bt3, 2048, 0, 0, false, scr, r / (DM / 64), r % (DM / 64), lane); continue; } r -= I_BA;
            if (r < I_BA) { transpose_item(P.w_bb, DM, Bt3, 2048, 1024, 0, false, scr, r / (DM / 64), r % (DM / 64), lane); continue; } r -= I_BA;
            if (r < I_OUT) { transpose_item(P.w_out, DM, Bt4, DM, 0, 0, false, scr, r / (DM / 64), r % (DM / 64), lane); continue; } r -= I_OUT;
            if (r < I_F1) { transpose_item(P.w_ff1, FF, Bt5, DM, 0, 0, false, scr, r / (FF / 64), r % (FF / 64), lane); continue; } r -= I_F1;
            transpose_item(P.w_ff2, DM, Bt6, FFP, 0, 0, false, scr, r / (DM / 64), r % (DM / 64), lane); continue; }
        if (r < I_IN) { transpose_item(P.w_in, IW, Bt1, DM, 0, 0, true, scr, r / (IW / 64), r % (IW / 64), lane); continue; } r -= I_IN;
        { const int g = r / 16, q = r % 16; transpose_item(P.w_pool + (size_t)g * 65536, 256, WpT, 256, 0, g * 256, false, scr, q / 4, q % 4, lane, P.pool_scale + g * 256); }
    }
    if (late) return;
    const int gt = bid * 512 + tid, NGT = G * 512;
    bf16_t* xb = (bf16_t*)(P.ws + WS_XB);
    for (int i = gt; i < S * DM / 8; i += NGT) { const f32x4 a = __builtin_nontemporal_load((const f32x4*)(P.x + (size_t)i * 8)), b = __builtin_nontemporal_load((const f32x4*)(P.x + (size_t)i * 8 + 4));
        u32x4 w; w.x = cvt_pk_bf16(a[0], a[1]); w.y = cvt_pk_bf16(a[2], a[3]); w.z = cvt_pk_bf16(b[0], b[1]); w.w = cvt_pk_bf16(b[2], b[3]); *(u32x4*)(xb + (size_t)i * 8) = w; }
    float* cosT = (float*)(P.ws + WS_COS); float* sinT = (float*)(P.ws + WS_SIN);
    const double invf_rev = exp(-(double)(gt & 63) * (9.210340371976184 / 64.0)) * 0.15915494309189535;
    for (int i = gt; i < S * 64; i += NGT) { const int t = i >> 6, f = i & 63;
        const double invf = (NGT & 63) ? exp(-(double)f * (9.210340371976184 / 64.0)) * 0.15915494309189535 : invf_rev; const double rev = (double)P.pos[t] * invf; const float fr = (float)(rev - floor(rev));
        cosT[i] = __builtin_amdgcn_cosf(fr); sinT[i] = __builtin_amdgcn_sinf(fr); }
}

__device__ __forceinline__ unsigned off_k(unsigned row, unsigned ch) { return 256u * row + 16u * (ch ^ (row & 15u)); }
__device__ __forceinline__ unsigned off_v(unsigned row, unsigned ch) { return 256u * row + 16u * (ch ^ ((row & 7u) << 1)); }
#define VTR(dst, addr, imm) asm volatile("ds_read_b64_tr_b16 %0, %1 offset:%c2" : "=&v"(dst) : "v"(addr), "i"(imm) : "memory")

__device__ __forceinline__ void attn_phase(const Ptrs& P, LAS unsigned char* lds, int G, int bid) {
    const int tid = threadIdx.x, lane = tid & 63, w = __builtin_amdgcn_readfirstlane(tid >> 6), ql = lane & 15, g = lane >> 4;
    const bf16_t* H1 = (const bf16_t*)(P.ws + WS_H1);
    bf16_t* OP = (bf16_t*)(P.ws + WS_OP); float* LSE = (float*)(P.ws + WS_LSE);
    LAS unsigned char* Ks = lds; LAS unsigned char* Vs = lds + 65536;
    const unsigned vbase = (unsigned)(size_t)Vs;
    const int srow = tid >> 4, sch = tid & 15;
    const unsigned soffK = off_k((unsigned)srow, (unsigned)sch), soffV = off_v((unsigned)srow, (unsigned)sch);
    unsigned vb[8];
    { const unsigned q4 = (unsigned)(lane & 15) >> 2, p4 = (unsigned)lane & 3;
#pragma unroll
      for (int c = 0; c < 8; ++c) vb[c] = vbase + off_v(16u * (unsigned)w + 4u * (unsigned)g + q4, 2u * c + (p4 >> 1)) + 8u * (p4 & 1u); }
#define ATT_DECODE(u_, p_, h_, r_, n_, dil_) const int p_ = (u_) >> 9, h_ = ((u_) & 511) >> 6; const int dil_ = 1 << (2 * p_); const int r_ = ((u_) & 63) >> (6 - 2 * p_), n_ = ((u_) & 63) & ((64 >> (2 * p_)) - 1)
    u32x4 kreg[8], vreg[8];
#define ATT_LOAD_TILE(dst, coloff, n_, dil_, r_, h_) do { _Pragma("unroll") for (int i = 0; i < 8; ++i) { dst[i] = (u32x4){0u, 0u, 0u, 0u}; \
        if (!((n_) == 0 && i < 4)) dst[i] = *(const u32x4*)(H1 + (size_t)((128 * ((n_) - 1) + srow + 32 * i) * (dil_) + (r_)) * 4096 + (coloff) + (h_) * 128 + sch * 8); } } while (0)
    { ATT_DECODE(bid, p, h, r, n, dil);
      if (bid < 3 * 512) { ATT_LOAD_TILE(kreg, 1024, n, dil, r, h); ATT_LOAD_TILE(vreg, 2048, n, dil, r, h); } }
    for (int u = bid; u < 3 * 512; u += G) {
        ATT_DECODE(u, p, h, r, n, dil);
#pragma unroll
        for (int i = 0; i < 8; ++i) *(LAS u32x4*)(Ks + soffK + 8192 * i) = kreg[i];
        const bool has_next = (u + G < 3 * 512);
        ATT_DECODE(u + G, p2, h2, r2, n2, dil2);
        if (has_next) ATT_LOAD_TILE(kreg, 1024, n2, dil2, r2, h2);
        const int qpos = (128 * n + 16 * w + ql) * dil + r;
        bf16x8 qf[4];
#pragma unroll
        for (int ks = 0; ks < 4; ++ks) qf[ks] = *(const bf16x8*)(H1 + (size_t)qpos * 4096 + h * 128 + 32 * ks + 8 * g);
        __syncthreads();
        f32x4 s[9];
        __builtin_amdgcn_s_setprio(1);
#pragma unroll
        for (int t = 0; t < 9; ++t) { s[t] = (f32x4){0.f, 0.f, 0.f, 0.f};
#pragma unroll
            for (int ks = 0; ks < 4; ++ks) { const bf16x8 kf = *(const LAS bf16x8*)(Ks + off_k(16 * (w + t) + ql, 4 * ks + g)); s[t] = __builtin_amdgcn_mfma_f32_16x16x32_bf16(kf, qf[ks], s[t], 0, 0, 0); } }
        __builtin_amdgcn_s_setprio(0);
        const float NEG = -INFINITY;
#pragma unroll
        for (int j = 0; j < 4; ++j) { const int kk = 4 * g + j; if (kk < ql) s[0][j] = NEG; if (kk > ql) s[8][j] = NEG; }
        if (n == 0) {
#pragma unroll
            for (int t = 0; t < 8; ++t) if (w + t < 8) s[t] = (f32x4){NEG, NEG, NEG, NEG}; }
        float mx = NEG;
#pragma unroll
        for (int t = 0; t < 9; ++t) mx = fmaxf(mx, fmaxf(fmaxf(s[t][0], s[t][1]), fmaxf(s[t][2], s[t][3])));
        mx = fmaxf(mx, __shfl_xor(mx, 16)); mx = fmaxf(mx, __shfl_xor(mx, 32));
        float l = 0.f;
#pragma unroll
        for (int t = 0; t < 9; ++t) {
#pragma unroll
            for (int j = 0; j < 4; ++j) { const float e = __builtin_amdgcn_exp2f(s[t][j] - mx); s[t][j] = e; l += e; } }
        l += __shfl_xor(l, 16); l += __shfl_xor(l, 32);
#pragma unroll
        for (int i = 0; i < 8; ++i) *(LAS u32x4*)(Vs + soffV + 8192 * i) = vreg[i];
        __syncthreads();
        f32x4 o[8];
#pragma unroll
        for (int c = 0; c < 8; ++c) o[c] = (f32x4){0.f, 0.f, 0.f, 0.f};
        s16x4 lo[2][8], hi[2][8];
#pragma unroll
        for (int c = 0; c < 8; ++c) { VTR(lo[0][c], vb[c], 0); VTR(hi[0][c], vb[c], 4096); }
#pragma unroll
        for (int kp = 0; kp < 5; ++kp) { const int t0 = 2 * kp, t1 = (2 * kp + 1 < 9) ? 2 * kp + 1 : 2 * kp;
            bf16x8 pf; { const unsigned a = cvt_pk_bf16(s[t0][0], s[t0][1]), b = cvt_pk_bf16(s[t0][2], s[t0][3]);
                unsigned c2 = 0u, d2 = 0u; if (2 * kp + 1 < 9) { c2 = cvt_pk_bf16(s[t1][0], s[t1][1]); d2 = cvt_pk_bf16(s[t1][2], s[t1][3]); }
                const u32x4 pw = (u32x4){a, b, c2, d2}; pf = __builtin_bit_cast(bf16x8, pw); }
            LDS_WAIT(); __builtin_amdgcn_sched_barrier(0);
            if (kp < 4) { const int u0 = 2 * (kp + 1), u1 = (2 * (kp + 1) + 1 < 9) ? 2 * (kp + 1) + 1 : 2 * (kp + 1);
#pragma unroll
                for (int c = 0; c < 8; ++c) { VTR(lo[(kp + 1) & 1][c], vb[c], 4096 * u0); VTR(hi[(kp + 1) & 1][c], vb[c], 4096 * u1); } }
            __builtin_amdgcn_sched_barrier(0); __builtin_amdgcn_s_setprio(1);
#pragma unroll
            for (int c = 0; c < 8; ++c) { const bf16x8 vf = (bf16x8){lo[kp & 1][c][0], lo[kp & 1][c][1], lo[kp & 1][c][2], lo[kp & 1][c][3], hi[kp & 1][c][0], hi[kp & 1][c][1], hi[kp & 1][c][2], hi[kp & 1][c][3]};
                o[c] = __builtin_amdgcn_mfma_f32_16x16x32_bf16(vf, pf, o[c], 0, 0, 0); }
            __builtin_amdgcn_s_setprio(0);
        }
        if (has_next) ATT_LOAD_TILE(vreg, 2048, n2, dil2, r2, h2);
        const float inv = 1.0f / l;
        LAS unsigned char* ost = lds + OST_OFF + w * 2304;
        const int orow = lane >> 2, oseg = lane & 3;
        bf16_t* op = OP + (size_t)p * S * AW + (size_t)((128 * n + 16 * w + orow) * dil + r) * AW + h * 128 + 16 * oseg;
#pragma unroll
        for (int hf = 0; hf < 2; ++hf) {
#pragma unroll
            for (int cc = 0; cc < 4; ++cc) { const int c = 4 * hf + cc; u32x2 wv; wv.x = cvt_pk_bf16(o[c][0] * inv, o[c][1] * inv); wv.y = cvt_pk_bf16(o[c][2] * inv, o[c][3] * inv);
                *(LAS u32x2*)(ost + ql * 144 + cc * 32 + g * 8) = wv; }
            asm volatile("" ::: "memory");
            const u32x4 r0 = *(const LAS u32x4*)(ost + orow * 144 + oseg * 32), r1 = *(const LAS u32x4*)(ost + orow * 144 + oseg * 32 + 16);
            asm volatile("" ::: "memory");
            *(u32x4*)(op + 64 * hf) = r0; *(u32x4*)(op + 64 * hf + 8) = r1;
        }
        if (g == 0) LSE[((size_t)p * S + qpos) * NH + h] = mx + __builtin_amdgcn_logf(l);
    }
    __syncthreads();
    bf16_t* Pp = (bf16_t*)(P.ws + WS_P);
    const int gt = bid * 512 + tid, NGT = G * 512;
    for (int i = gt; i < (S / 32) * 128; i += NGT) { const int ch = i & 127, t0 = (i >> 7) * 32; const int win = 2 << (ch >> 5);
        const bf16_t* src = H1 + (size_t)t0 * 4096 + 3072 + ch * 8;
        float ws8[8];
#pragma unroll
        for (int e = 0; e < 8; ++e) ws8[e] = 0.f;
        for (int j = 1; j <= win; ++j) if (t0 - j >= 0) { const u32x4 y = *(const u32x4*)(src - (size_t)j * 4096);
            ws8[0] += bf_lo(y.x); ws8[1] += bf_hi(y.x); ws8[2] += bf_lo(y.y); ws8[3] += bf_hi(y.y); ws8[4] += bf_lo(y.z); ws8[5] += bf_hi(y.z); ws8[6] += bf_lo(y.w); ws8[7] += bf_hi(y.w); }
#pragma unroll 8
        for (int s = 0; s < 32; ++s) { const int t = t0 + s; const u32x4 x0 = *(const u32x4*)(src + (size_t)s * 4096);
            u32x4 y = (u32x4){0u, 0u, 0u, 0u}; if (t - win >= 0) y = *(const u32x4*)(src + (size_t)(s - win) * 4096);
            const float xs[8] = {bf_lo(x0.x), bf_hi(x0.x), bf_lo(x0.y), bf_hi(x0.y), bf_lo(x0.z), bf_hi(x0.z), bf_lo(x0.w), bf_hi(x0.w)};
            const float ys[8] = {bf_lo(y.x), bf_hi(y.x), bf_lo(y.y), bf_hi(y.y), bf_lo(y.z), bf_hi(y.z), bf_lo(y.w), bf_hi(y.w)};
            const int cnt = (t + 1 < win) ? t + 1 : win; const float ic = 1.0f / (float)cnt;
            float pv[8];
#pragma unroll
            for (int e = 0; e < 8; ++e) { ws8[e] += xs[e] - ys[e]; pv[e] = ws8[e] * ic - xs[e]; }
            u32x4 wv; wv.x = cvt_pk_bf16(pv[0], pv[1]); wv.y = cvt_pk_bf16(pv[2], pv[3]); wv.z = cvt_pk_bf16(pv[4], pv[5]); wv.w = cvt_pk_bf16(pv[6], pv[7]);
            *(u32x4*)(Pp + (size_t)t * AW + ch * 8) = wv; }
    }
}

__device__ __forceinline__ void combine_phase(const Ptrs& P, int G, int bid) {
    const bf16_t* OP = (const bf16_t*)(P.ws + WS_OP); const float* LSE = (const float*)(P.ws + WS_LSE); bf16_t* A3 = (bf16_t*)(P.ws + WS_A3);
    int start, cnt;
    if (G == 256) { start = (bid < 128) ? bid * 2048 : 128 * 2048 + (bid - 128) * 6144; cnt = (bid < 128) ? 2048 : 6144; }
    else { const int per = (S * 128 + G - 1) / G; start = bid * per; cnt = (start + per <= S * 128) ? per : (S * 128 > start ? S * 128 - start : 0); }
    for (int b0 = threadIdx.x; b0 < cnt; b0 += 4 * 512) {
        u32x4 a[4], b[4], c[4]; float l0[4], l1[4], l2[4];
#pragma unroll
        for (int k = 0; k < 4; ++k) { const int ii = b0 + 512 * k; const int i = start + (ii < cnt ? ii : b0); const int t = i >> 7, ch = i & 127, h = ch >> 4;
            l0[k] = LSE[((size_t)0 * S + t) * NH + h]; l1[k] = LSE[((size_t)1 * S + t) * NH + h]; l2[k] = LSE[((size_t)2 * S + t) * NH + h];
            const size_t off = (size_t)t * AW + ch * 8;
            a[k] = __builtin_nontemporal_load((const u32x4*)(OP + off)); b[k] = __builtin_nontemporal_load((const u32x4*)(OP + (size_t)S * AW + off)); c[k] = __builtin_nontemporal_load((const u32x4*)(OP + 2 * (size_t)S * AW + off)); }
#pragma unroll
        for (int k = 0; k < 4; ++k) { const int ii = b0 + 512 * k; if (ii < cnt) { const int i = start + ii; const int t = i >> 7, ch = i & 127;
            const float m = fmaxf(l0[k], fmaxf(l1[k], l2[k])); float w0 = __builtin_amdgcn_exp2f(l0[k] - m), w1 = __builtin_amdgcn_exp2f(l1[k] - m), w2 = __builtin_amdgcn_exp2f(l2[k] - m);
            const float is = 1.0f / (w0 + w1 + w2); w0 *= is; w1 *= is; w2 *= is;
            u32x4 wv;
            wv.x = cvt_pk_bf16(w0 * bf_lo(a[k].x) + w1 * bf_lo(b[k].x) + w2 * bf_lo(c[k].x), w0 * bf_hi(a[k].x) + w1 * bf_hi(b[k].x) + w2 * bf_hi(c[k].x));
            wv.y = cvt_pk_bf16(w0 * bf_lo(a[k].y) + w1 * bf_lo(b[k].y) + w2 * bf_lo(c[k].y), w0 * bf_hi(a[k].y) + w1 * bf_hi(b[k].y) + w2 * bf_hi(c[k].y));
            wv.z = cvt_pk_bf16(w0 * bf_lo(a[k].z) + w1 * bf_lo(b[k].z) + w2 * bf_lo(c[k].z), w0 * bf_hi(a[k].z) + w1 * bf_hi(b[k].z) + w2 * bf_hi(c[k].z));
            wv.w = cvt_pk_bf16(w0 * bf_lo(a[k].w) + w1 * bf_lo(b[k].w) + w2 * bf_lo(c[k].w), w0 * bf_hi(a[k].w) + w1 * bf_hi(b[k].w) + w2 * bf_hi(c[k].w));
            *(u32x4*)(A3 + (size_t)t * DM + ch * 8) = wv; } }
    }
}

__device__ __forceinline__ float wave_sum(float v) {
#pragma unroll
    for (int o = 1; o < 64; o <<= 1) v += __shfl_xor(v, o);
    return v;
}
__device__ __forceinline__ void ln_phase(float* X, const float* gam, const float* bet, bf16_t* xb, int G, int bid) {
    const int lane = threadIdx.x & 63, wave = threadIdx.x >> 6; const int gw = bid * 8 + wave, NGW = G * 8;
    for (int row = gw; row < S; row += NGW) { f32x4* xr = (f32x4*)(X + (size_t)row * DM) + lane;
        f32x4 v[8]; float s = 0.f;
#pragma unroll
        for (int j = 0; j < 8; ++j) { v[j] = xr[64 * j]; s += (v[j][0] + v[j][1]) + (v[j][2] + v[j][3]); }
        const float mean = wave_sum(s) * (1.0f / DM); float s2 = 0.f;
#pragma unroll
        for (int j = 0; j < 8; ++j) { v[j] = v[j] - mean; s2 += (v[j][0] * v[j][0] + v[j][1] * v[j][1]) + (v[j][2] * v[j][2] + v[j][3] * v[j][3]); }
        const float rstd = 1.0f / sqrtf(wave_sum(s2) * (1.0f / DM) + LN_EPS);
#pragma unroll
        for (int j = 0; j < 8; ++j) { const f32x4 gg = *((const f32x4*)gam + lane + 64 * j), bb = *((const f32x4*)bet + lane + 64 * j); const f32x4 y = v[j] * rstd * gg + bb; xr[64 * j] = y;
            if (xb) { u32x2 wv; wv.x = cvt_pk_bf16(y[0], y[1]); wv.y = cvt_pk_bf16(y[2], y[3]); *((u32x2*)(xb + (size_t)row * DM) + lane + 64 * j) = wv; } }
    }
}

struct Args { const void* in[14]; float* out; unsigned char* ws; int ph_lo, ph_hi; };
__global__ void __launch_bounds__(512, 2) mega_fwd(Args a) {
    extern __shared__ __attribute__((aligned(16))) unsigned char lds_raw[];
    LAS unsigned char* lds = (LAS unsigned char*)lds_raw;
    Ptrs P;
    P.x = (const float*)a.in[0]; P.pos = (const int*)a.in[1]; P.w_in = (const float*)a.in[2]; P.w_pool = (const float*)a.in[3]; P.pool_scale = (const float*)a.in[4];
    P.w_ba = (const float*)a.in[5]; P.w_bb = (const float*)a.in[6]; P.w_out = (const float*)a.in[7]; P.ln1g = (const float*)a.in[8]; P.ln1b = (const float*)a.in[9];
    P.w_ff1 = (const float*)a.in[10]; P.w_ff2 = (const float*)a.in[11]; P.ln2g = (const float*)a.in[12]; P.ln2b = (const float*)a.in[13]; P.out = a.out; P.ws = a.ws;
    const int G = gridDim.x, bid = blockIdx.x;
    const int lo = a.ph_lo, hi = a.ph_hi;
    unsigned char* ws = a.ws;
#ifndef PHASE_MASK
#define PHASE_MASK 0x3ff
#endif
#define IN(k) (((PHASE_MASK >> (k)) & 1) && lo <= (k) && (k) < hi)
    volatile LAS unsigned* bst = (volatile LAS unsigned*)(lds + 131072 + 64);
    if (threadIdx.x < 2) bst[threadIdx.x] = 0u;
    __syncthreads();
    XcdBarrier xbar; xbar.bar = (unsigned*)ws; xbar.x = 0; xbar.st = bst;
    xbar = xcd_barrier_post((unsigned*)ws, bst);
#define SEAM(k) do { if (IN(k) && IN((k) + 1)) { if (hi > NPH) cg::this_grid().sync();   else xcd_barrier(xbar); } } while (0)
#ifndef REP_MASK
#define REP_MASK 0
#endif
    if (IN(0)) { p0_prologue<false>(P, lds, G, bid); __syncthreads(); }
    SEAM(0);
    if (REP_MASK & 1024) { xcd_barrier(xbar); xcd_barrier(xbar); xcd_barrier(xbar); xcd_barrier(xbar); }
    if (IN(1)) {
        pg8::Gemm g{(const bf16_t*)(ws + WS_XB), (const bf16_t*)(ws + WS_BT1), DM, DM, DM, 0}; pg8::StaticOrder so; so.init(S, IW, G, bid, 1);
        pg8::Epi1 E{(bf16_t*)(ws + WS_H1), (bf16_t*)(ws + WS_G), (const float*)(ws + WS_COS), (const float*)(ws + WS_SIN)};
        pg8::gemm_phase(lds, g, so, E);
        if (REP_MASK & 2) { __syncthreads(); pg8::gemm_phase(lds, g, so, E); }
    }
    SEAM(1);
    if (IN(2)) { const int vcu = (G % 8 == 0) ? (bid % 8) * (G / 8) + bid / 8 : bid;
        attn_phase(P, lds, G, vcu); if (REP_MASK & 4) { __syncthreads(); attn_phase(P, lds, G, vcu); } }
    SEAM(2);
    if (IN(3)) {
        pg8::Gemm g{(const bf16_t*)(ws + WS_P), (const bf16_t*)(ws + WS_WPT), AW, 256, 256, 512}; pg8::StaticOrder so; so.init(S, 1024, G, bid);
        pg8::EpiBf16<0> E{(bf16_t*)(ws + WS_A3), DM, 1024, nullptr};
        pg8::gemm_phase(lds, g, so, E);
        combine_phase(P, G, bid);
        p0_prologue<true>(P, lds, G, bid);
    }
    SEAM(3);
    if (IN(4)) {
        pg8::Gemm g{(const bf16_t*)(ws + WS_A3), (const bf16_t*)(ws + WS_BT3), DM, 2048, 1024  , 0}; pg8::StaticOrder so; so.init(S, DM, G, bid);
        pg8::Epi3 E{(bf16_t*)(ws + WS_MRG), (const bf16_t*)(ws + WS_G)};
        pg8::gemm_phase(lds, g, so, E);
        if (REP_MASK & 16) { __syncthreads(); pg8::gemm_phase(lds, g, so, E); }
    }
    SEAM(4);
    if (IN(5)) {
        pg8::Gemm g{(const bf16_t*)(ws + WS_MRG), (const bf16_t*)(ws + WS_BT4), DM, DM, DM, 0}; pg8::StaticOrder so; so.init(S, DM, G, bid);
        pg8::EpiResLn<false> E{P.x, nullptr, nullptr, (bf16_t*)(ws + WS_X1B), P.ln1g, P.ln1b, (float*)(ws + WS_ST1), (unsigned*)(ws + 16384)};
        pg8::gemm_phase(lds, g, so, E);
    }
    SEAM(5);
    if (IN(7)) {
        pg8::Gemm g{(const bf16_t*)(ws + WS_X1B), (const bf16_t*)(ws + WS_BT5), DM, DM, DM, 0}; pg8::StaticOrder so; so.init(S, FF, G, bid);
        pg8::EpiBf16<1> E{(bf16_t*)(ws + WS_ACT), FFP, 0, nullptr};
        pg8::gemm_phase(lds, g, so, E);
        if (REP_MASK & 128) { __syncthreads(); pg8::gemm_phase(lds, g, so, E); }
    }
    SEAM(7);
    if (IN(8)) {
        pg8::Gemm g{(const bf16_t*)(ws + WS_ACT), (const bf16_t*)(ws + WS_BT6), FFP, FFP, FF, 0}; pg8::StaticOrder so; so.init(S, DM, G, bid);

        pg8::EpiResLn<true> E{nullptr, (const bf16_t*)(ws + WS_X1B), P.out, nullptr, P.ln2g, P.ln2b, (float*)(ws + WS_ST2), (unsigned*)(ws + 24576)};
        pg8::gemm_phase(lds, g, so, E);
    }
#undef IN
#undef SEAM
}

#ifdef DBG_STOP
__global__ void dbg_dump(const bf16_t* src, float* out, int n) { for (int i = blockIdx.x * blockDim.x + threadIdx.x; i < n; i += gridDim.x * blockDim.x) out[i] = __builtin_bit_cast(float, (unsigned)src[i] << 16); }
#endif
extern "C" void kernel_launch(void* const* d_in, const int* in_sizes, int n_in, void* d_out, int out_size, void* d_ws, size_t ws_size, hipStream_t stream) {
    static int grid = 0;
    if (grid == 0) {
        if (n_in != 14 || out_size != S * DM || ws_size < WS_END) { fprintf(stderr, "kernel_launch: unexpected problem (n_in %d, out %d, ws %zu < %zu)\n", n_in, out_size, ws_size, (size_t)WS_END); grid = -1; return; }
        if (hipFuncSetAttribute((const void*)mega_fwd, hipFuncAttributeMaxDynamicSharedMemorySize, LDS_BYTES) != hipSuccess) { fprintf(stderr, "kernel_launch: hipFuncSetAttribute failed\n"); grid = -1; return; }
        int dev = 0, cus = 0, per_cu = 0;
        hipGetDevice(&dev); hipDeviceGetAttribute(&cus, hipDeviceAttributeMultiprocessorCount, dev);
        hipOccupancyMaxActiveBlocksPerMultiprocessor(&per_cu, (const void*)mega_fwd, 512, LDS_BYTES);
        if (per_cu < 1) { fprintf(stderr, "kernel_launch: occupancy query says %d blocks per CU\n", per_cu); per_cu = 1; }
        (void)hipGetLastError();
        grid = cus;
    }
    if (grid < 0) return;
    Args a{};
    for (int i = 0; i < 14; ++i) a.in[i] = d_in[i];
    a.out = (float*)d_out; a.ws = (unsigned char*)d_ws;
#if N_LAUNCH_MODE == 0
    if (hipMemsetAsync(d_ws, 0, WS_ZERO_BYTES, stream) != hipSuccess) { fprintf(stderr, "kernel_launch: memset of the barrier words failed\n"); return; }
    a.ph_lo = 0; a.ph_hi = NPH;
    void* args[] = {&a};
    hipError_t e = hipLaunchCooperativeKernel((const void*)mega_fwd, dim3(grid), dim3(512), args, LDS_BYTES, stream);
    if (e != hipSuccess) fprintf(stderr, "cooperative launch failed: %s (grid %d)\n", hipGetErrorString(e), grid);
#else
#ifdef DBG_STOP
    for (int ph = 0; ph <= DBG_STOP; ++ph) { a.ph_lo = ph; a.ph_hi = ph + 1; hipLaunchKernelGGL(mega_fwd, dim3(grid), dim3(512), LDS_BYTES, stream, a); }
    hipLaunchKernelGGL(dbg_dump, dim3(2048), dim3(256), 0, stream, (const bf16_t*)((unsigned char*)d_ws + (size_t)DBG_OFF * MiB), (float*)d_out, S * DM);
#else
    for (int ph = 0; ph < NPH; ++ph) { a.ph_lo = ph; a.ph_hi = ph + 1; hipLaunchKernelGGL(mega_fwd, dim3(grid), dim3(512), LDS_BYTES, stream, a); }
#endif
#endif
}
```
